# Optimizing an MI355X kernel written in HIP

```python
import math
import jax, jax.numpy as jnp
from jax import lax
import numpy as np


D_MODEL = 2048
BATCH = 16
SEQ = 2048
DEPTH = 1

CHUNK = 64
EPS = 1e-6
SSM_WIDTH = D_MODEL // 4
SSM_GROUP = 16
SSM_GROUPS = SSM_WIDTH // SSM_GROUP
SSM_STATE = 64
MLSTM_WIDTH = D_MODEL - SSM_WIDTH
MLSTM_HEADS = 4
MLSTM_HEAD_DIM = MLSTM_WIDTH // MLSTM_HEADS
CONV_WIDTH = 4
PEER_HEADS = 8
PEER_QUERY_DIM = 256
PEER_NKEYS = 128
PEER_TOPK = 16
PEER_EXPERTS = PEER_NKEYS * PEER_NKEYS
PEER_TOKEN_BLOCK = 128
IN_SPLITS = (SSM_WIDTH, MLSTM_WIDTH, MLSTM_WIDTH, MLSTM_HEADS, MLSTM_HEADS, D_MODEL, D_MODEL)
IN_WIDTH = sum(IN_SPLITS)
IN_OFFSETS = tuple(int(o) for o in np.cumsum(IN_SPLITS)[:-1])

kernel_name = 'hybrid_s5_mlstm_peer_block'


def rmsnorm(x, g):
    xf = x.astype(jnp.float32)
    y = xf * lax.rsqrt(jnp.mean(xf * xf, axis=-1, keepdims=True) + EPS)
    return (y * g.astype(jnp.float32)).astype(x.dtype)


def s5_branch(u, lam_re, lam_im, log_dt, b_re, b_im, c_re, c_im, d_skip, w_glu):
    bsz, seq, _ = u.shape
    f32 = jnp.float32
    uf = u.astype(f32).reshape(bsz, seq, SSM_GROUPS, SSM_GROUP)
    lam = lax.complex(lam_re.astype(f32), lam_im.astype(f32))
    dt = jnp.exp(log_dt.astype(f32))[:, None]
    a_bar = jnp.exp(lam * dt)
    b_bar = ((a_bar - 1.0) / lam)[..., None] * lax.complex(b_re.astype(f32), b_im.astype(f32))
    bu = jnp.einsum('gph,bsgh->bsgp', b_bar, uf.astype(jnp.complex64))
    a_full = jnp.broadcast_to(a_bar, bu.shape)

    def combine(left, right):
        a_l, b_l = left
        a_r, b_r = right
        return a_r * a_l, a_r * b_l + b_r

    _, states = lax.associative_scan(combine, (a_full, bu), axis=1)
    c = lax.complex(c_re.astype(f32), c_im.astype(f32))
    y = jnp.real(jnp.einsum('ghp,bsgp->bsgh', c, states)) + d_skip.astype(f32).reshape(SSM_GROUPS, SSM_GROUP) * uf
    y = jax.nn.gelu(y.reshape(bsz, seq, SSM_WIDTH)).astype(u.dtype)
    val, gate = jnp.split(y @ w_glu, 2, axis=-1)
    return val * jax.nn.sigmoid(gate)


def causal_conv(x, w, b):
    seq = x.shape[1]
    xp = jnp.pad(x, ((0, 0), (CONV_WIDTH - 1, 0), (0, 0)))
    out = b
    for j in range(CONV_WIDTH):
        out = out + xp[:, j:j + seq] * w[j]
    return out


def _to_chunks(t):
    b, s = t.shape[:2]
    t = t.reshape((b, s // CHUNK, CHUNK) + t.shape[2:])
    t = jnp.swapaxes(t, 2, 3)
    return jnp.moveaxis(t, 1, 0)


def mlstm_chunkwise(q, k, v, i_pre, logf):
    bsz, seq, nh, dk = q.shape
    dv = v.shape[-1]
    f32 = jnp.float32
    causal = jnp.tril(jnp.ones((CHUNK, CHUNK), dtype=bool))

    def step(carry, inp):
        c_prev, n_prev, m_prev = carry
        qc, kc, vc, ic, fc = inp
        bcum = jnp.cumsum(fc, axis=-1)
        log_w = bcum[..., :, None] - bcum[..., None, :] + ic[..., None, :]
        log_w = jnp.where(causal, log_w, -jnp.inf)
        log_inter = bcum + m_prev[..., None]
        m_t = jnp.maximum(log_inter, jnp.max(log_w, axis=-1))
        w = jnp.exp(log_w - m_t[..., None])
        inter = jnp.exp(log_inter - m_t)
        sw = jnp.einsum('bhtd,bhsd->bhts', qc, kc) * w
        num = jnp.einsum('bhts,bhse->bhte', sw, vc) + inter[..., None] * jnp.einsum('bhed,bhtd->bhte', c_prev, qc)
        den = jnp.sum(sw, axis=-1) + inter * jnp.einsum('bhd,bhtd->bht', n_prev, qc)
        h = num / jnp.maximum(jnp.abs(den), jnp.exp(-m_t))[..., None]
        b_last = bcum[..., -1]
        m_new = m_t[..., -1]
        w_end = jnp.exp(b_last[..., None] - bcum + ic - m_new[..., None])
        decay = jnp.exp(b_last + m_prev - m_new)
        c_new = decay[..., None, None] * c_prev + jnp.einsum('bhs,bhse,bhsd->bhed', w_end, vc, kc)
        n_new = decay[..., None] * n_prev + jnp.einsum('bhs,bhsd->bhd', w_end, kc)
        return (c_new, n_new, m_new), h

    init = (jnp.zeros((bsz, nh, dv, dk), f32), jnp.zeros((bsz, nh, dk), f32), jnp.zeros((bsz, nh), f32))
    xs = (_to_chunks(q), _to_chunks(k), _to_chunks(v), _to_chunks(i_pre), _to_chunks(logf))
    _, hs = lax.scan(step, init, xs)
    hs = jnp.swapaxes(jnp.moveaxis(hs, 0, 1), 2, 3)
    return hs.reshape(bsz, seq, nh, dv)


def mlstm_branch(xm, z, i_raw, f_raw, conv_w, conv_b, w_q, w_k, w_v, b_i, b_f, mh_gain, skip, w_proj):
    bsz, seq, _ = xm.shape
    f32 = jnp.float32
    heads = lambda t: t.reshape(bsz, seq, MLSTM_HEADS, MLSTM_HEAD_DIM)
    xc = jax.nn.silu(causal_conv(xm, conv_w, conv_b))
    q = jnp.einsum('bshd,hde->bshe', heads(xc), w_q).astype(f32)
    k = (jnp.einsum('bshd,hde->bshe', heads(xc), w_k) * MLSTM_HEAD_DIM ** -0.5).astype(f32)
    v = jnp.einsum('bshd,hde->bshe', heads(xm), w_v).astype(f32)
    i_pre = (i_raw + b_i).astype(f32)
    logf = jax.nn.log_sigmoid((f_raw + b_f).astype(f32))
    h = mlstm_chunkwise(q, k, v, i_pre, logf)
    h = jax.nn.sigmoid(heads(z).astype(f32)) * h
    mu = jnp.mean(h, axis=-1, keepdims=True)
    var = jnp.mean(jnp.square(h - mu), axis=-1, keepdims=True)
    h = ((h - mu) * lax.rsqrt(var + EPS)).reshape(bsz, seq, MLSTM_WIDTH)
    h = h * mh_gain.astype(f32) + skip.astype(f32) * xc.astype(f32)
    return h.astype(xm.dtype) @ w_proj


def peer(h, w_query, key1, key2, expert_u, expert_v):
    bsz, seq, d = h.shape
    n_tok = bsz * seq
    hk = PEER_HEADS * PEER_TOPK
    t = h.reshape(n_tok, d)
    qr = (t @ w_query).reshape(n_tok, PEER_HEADS, PEER_QUERY_DIM)
    q1, q2 = jnp.split(qr, 2, axis=-1)
    s1 = jnp.einsum('thd,hnd->thn', q1, key1).astype(jnp.float32)
    s2 = jnp.einsum('thd,hnd->thn', q2, key2).astype(jnp.float32)
    v1, i1 = lax.top_k(s1, PEER_TOPK)
    v2, i2 = lax.top_k(s2, PEER_TOPK)
    cand = (v1[..., :, None] + v2[..., None, :]).reshape(n_tok, PEER_HEADS, PEER_TOPK * PEER_TOPK)
    cand_idx = (i1[..., :, None] * PEER_NKEYS + i2[..., None, :]).reshape(n_tok, PEER_HEADS, PEER_TOPK * PEER_TOPK)
    top_s, pos = lax.top_k(cand, PEER_TOPK)
    experts = jnp.take_along_axis(cand_idx, pos, axis=-1)
    gates = jax.nn.softmax(top_s, axis=-1).astype(h.dtype)

    def block(args):
        tb, eb, gb = args
        u = jnp.take(expert_u, eb, axis=0)
        act = jax.nn.gelu(jnp.einsum('ted,td->te', u, tb)) * gb
        vv = jnp.take(expert_v, eb, axis=0)
        return jnp.einsum('te,ted->td', act, vv)

    nb = n_tok // PEER_TOKEN_BLOCK
    out = lax.map(block, (t.reshape(nb, PEER_TOKEN_BLOCK, d),
                          experts.reshape(nb, PEER_TOKEN_BLOCK, hk),
                          gates.reshape(nb, PEER_TOKEN_BLOCK, hk)))
    return out.reshape(bsz, seq, d)


def setup_inputs(seed: int = 0) -> dict:
    key = jax.random.key(seed)
    keys = jax.random.split(key, 40)
    cnt = [0]
    f32 = jnp.float32

    def nk():
        cnt[0] += 1
        return keys[cnt[0] - 1]

    def nrm(shape, scale):
        return jax.random.normal(nk(), shape, f32) * scale

    L = DEPTH
    G, P, H = SSM_GROUPS, SSM_STATE, SSM_GROUP
    hd = MLSTM_HEAD_DIM
    half = PEER_QUERY_DIM // 2
    return {
        'x': nrm((BATCH, SEQ, D_MODEL), 1.0),
        'norm1_g': 1.0 + nrm((L, D_MODEL), 0.02),
        'w_in': nrm((L, D_MODEL, IN_WIDTH), D_MODEL ** -0.5),
        'lam_re': -0.5 + nrm((L, G, P), 0.01),
        'lam_im': jnp.pi * jnp.arange(P, dtype=f32) + nrm((L, G, P), 0.01),
        'log_dt': jax.random.uniform(nk(), (L, G), f32, math.log(1e-3), math.log(1e-1)),
        'b_re': nrm((L, G, P, H), (2 * H) ** -0.5),
        'b_im': nrm((L, G, P, H), (2 * H) ** -0.5),
        'c_re': nrm((L, G, H, P), (2 * P) ** -0.5),
        'c_im': nrm((L, G, H, P), (2 * P) ** -0.5),
        'd_skip': nrm((L, SSM_WIDTH), 1.0),
        'w_glu': nrm((L, SSM_WIDTH, 2 * D_MODEL), SSM_WIDTH ** -0.5),
        'conv_w': nrm((L, CONV_WIDTH, MLSTM_WIDTH), 0.5),
        'conv_b': nrm((L, MLSTM_WIDTH), 0.02),
        'w_q': nrm((L, MLSTM_HEADS, hd, hd), hd ** -0.5),
        'w_k': nrm((L, MLSTM_HEADS, hd, hd), hd ** -0.5),
        'w_v': nrm((L, MLSTM_HEADS, hd, hd), hd ** -0.5),
        'b_i': nrm((L, MLSTM_HEADS), 0.1),
        'b_f': jnp.linspace(3.0, 6.0, MLSTM_HEADS, dtype=f32) + nrm((L, MLSTM_HEADS), 0.1),
        'mh_gain': 1.0 + nrm((L, MLSTM_WIDTH), 0.02),
        'mlstm_skip': 1.0 + nrm((L, MLSTM_WIDTH), 0.02),
        'w_mlstm_out': nrm((L, MLSTM_WIDTH, D_MODEL), MLSTM_WIDTH ** -0.5),
        'w_out': nrm((L, D_MODEL, D_MODEL), D_MODEL ** -0.5),
        'norm2_g': 1.0 + nrm((L, D_MODEL), 0.02),
        'w_query': nrm((L, D_MODEL, PEER_HEADS * PEER_QUERY_DIM), D_MODEL ** -0.5),
        'key1': nrm((L, PEER_HEADS, PEER_NKEYS, half), half ** -0.5),
        'key2': nrm((L, PEER_HEADS, PEER_NKEYS, half), half ** -0.5),
        'expert_u': nrm((L, PEER_EXPERTS, D_MODEL), D_MODEL ** -0.5),
        'expert_v': nrm((L, PEER_EXPERTS, D_MODEL), (PEER_HEADS * PEER_TOPK) ** -0.5),
        'norm_f_g': 1.0 + nrm((D_MODEL,), 0.02),
    }


def reference(x, norm1_g, w_in, lam_re, lam_im, log_dt, b_re, b_im, c_re, c_im, d_skip, w_glu,
              conv_w, conv_b, w_q, w_k, w_v, b_i, b_f, mh_gain, mlstm_skip, w_mlstm_out, w_out,
              norm2_g, w_query, key1, key2, expert_u, expert_v, norm_f_g):
    h = x
    for l in range(DEPTH):
        hn = rmsnorm(h, norm1_g[l])
        proj = hn @ w_in[l]
        u_ssm, xm, z, i_raw, f_raw, g_a, g_b = jnp.split(proj, IN_OFFSETS, axis=-1)
        y_a = s5_branch(u_ssm, lam_re[l], lam_im[l], log_dt[l], b_re[l], b_im[l],
                        c_re[l], c_im[l], d_skip[l], w_glu[l])
        y_b = mlstm_branch(xm, z, i_raw, f_raw, conv_w[l], conv_b[l], w_q[l], w_k[l], w_v[l],
                           b_i[l], b_f[l], mh_gain[l], mlstm_skip[l], w_mlstm_out[l])
        merged = jax.nn.sigmoid(g_a) * y_a + jax.nn.sigmoid(g_b) * y_b
        h = h + merged @ w_out[l]
        h = h + peer(rmsnorm(h, norm2_g[l]), w_query[l], key1[l], key2[l], expert_u[l], expert_v[l])
    return rmsnorm(h, norm_f_g)
```

```cpp
#include <hip/hip_runtime.h>
#include <hip/hip_cooperative_groups.h>
#include <cstdio>
namespace cg = cooperative_groups;

#ifndef MULTI
#define MULTI 0
#endif
#ifndef PROBE13
#define PROBE13 0
#endif
#ifndef REPMASK
#define REPMASK 0
#endif

typedef unsigned short u16;
typedef __attribute__((ext_vector_type(8))) short bf16x8;
typedef __attribute__((ext_vector_type(4))) float f32x4;
typedef __attribute__((ext_vector_type(4))) unsigned u32x4;

constexpr int T = 32768, D = 2048;
constexpr int NT = 512, BK = 64, LROW = 72;
constexpr int GEMM_LDS = 2 * (256 + 128) * LROW * 2;
constexpr int LDS_BYTES = 151552;
constexpr int NPH = 18;

constexpr size_t MBy = 1u << 20;
constexpr size_t OFF_WIN = 0, OFF_WGLU = 31 * MBy, OFF_WQ = 35 * MBy, OFF_WK = 37 * MBy, OFF_WV = 39 * MBy,
                 OFF_WMO = 41 * MBy, OFF_WOUT = 47 * MBy, OFF_WQRY = 55 * MBy, OFF_KEY1 = 63 * MBy,
                 OFF_KEY2 = 63 * MBy + 512 * 1024, OFF_KMAT = 64 * MBy, OFF_EMAT = 65 * MBy, OFF_MMAT = 73 * MBy,
                 OFF_AL = 81 * MBy, OFF_GIF = 82 * MBy, OFF_GATES = 83 * MBy, OFF_V5 = 87 * MBy, OFF_X5 = 95 * MBy,
                 OFF_R1 = 100 * MBy, OFF_R2 = 228 * MBy, OFF_R3 = 324 * MBy, OFF_R6 = 420 * MBy, OFF_R7 = 452 * MBy,
                 OFF_R4 = 548 * MBy, OFF_R5 = 676 * MBy, OFF_R8 = 804 * MBy, OFF_R9 = 900 * MBy, OFF_R10 = 996 * MBy,
                 WS_END = 1012 * MBy;
constexpr size_t OFF_ESC = 81 * MBy + 128 * 1024;
constexpr size_t OFF_H1B = OFF_R2 + 64 * MBy;
constexpr size_t OFF_CTL = 81 * MBy + 512 * 1024;

struct KArgs { const float* in[30]; float* out; unsigned char* ws; int ph_lo, ph_hi; };

__device__ __forceinline__ u16 f2bf(float f) { unsigned u = __float_as_uint(f); u += 0x7fffu + ((u >> 16) & 1u); return (u16)(u >> 16); }
__device__ __forceinline__ float bf2f(u16 h) { return __uint_as_float(((unsigned)h) << 16); }
__device__ __forceinline__ float bflo(unsigned u) { return __uint_as_float(u << 16); }
__device__ __forceinline__ float bfhi(unsigned u) { return __uint_as_float(u & 0xffff0000u); }
__device__ __forceinline__ unsigned pack2(float a, float b) { return (unsigned)f2bf(a) | ((unsigned)f2bf(b) << 16); }
__device__ __forceinline__ float sigm(float x) { return 1.f / (1.f + __expf(-x)); }
__device__ __forceinline__ float gelu_t(float x) { return x * sigm(1.5957691216f * (x + 0.044715f * x * x * x)); }
__device__ __forceinline__ float wave_sum(float v) {
#pragma unroll
  for (int o = 32; o; o >>= 1) v += __shfl_xor(v, o);
  return v;
}
__device__ __forceinline__ unsigned wave_maxu(unsigned v) {
#pragma unroll
  for (int o = 32; o; o >>= 1) { unsigned t = (unsigned)__shfl_xor((int)v, o); v = t > v ? t : v; }
  return v;
}
__device__ __forceinline__ unsigned ordkey(float f) { unsigned u = __float_as_uint(f); return (u & 0x80000000u) ? ~u : (u | 0x80000000u); }


typedef __attribute__((ext_vector_type(2))) float f32x2;
__device__ __forceinline__ float wave_maxf(float v) {
#pragma unroll
  for (int o = 32; o; o >>= 1) v = fmaxf(v, __shfl_xor(v, o));
  return v;
}
__device__ __forceinline__ unsigned pk4_fp8(float4 f, float sc) {
  int w = 0;
  w = __builtin_amdgcn_cvt_pk_fp8_f32(f.x * sc, f.y * sc, w, false);
  w = __builtin_amdgcn_cvt_pk_fp8_f32(f.z * sc, f.w * sc, w, true);
  return (unsigned)w;
}
__device__ __forceinline__ void convert_fp8_rows(const float* __restrict__ src, unsigned char* __restrict__ dst, float* __restrict__ inv_scale, int nrows) {
  const int lane = threadIdx.x & 63; const int gw = blockIdx.x * 8 + (threadIdx.x >> 6); const int nw = gridDim.x * 8;
  for (int r = gw; r < nrows; r += nw) {
    const float4* p = (const float4*)(src + (size_t)r * 2048);
    float4 v[8]; float mx = 0.f;
#pragma unroll
    for (int i = 0; i < 2; ++i)
#pragma unroll
      for (int q = 0; q < 4; ++q) {
        { const f32x4 t4 = __builtin_nontemporal_load((const f32x4*)p + i * 256 + lane * 4 + q); v[i * 4 + q] = make_float4(t4[0], t4[1], t4[2], t4[3]); }
        mx = fmaxf(mx, fmaxf(fmaxf(fabsf(v[i * 4 + q].x), fabsf(v[i * 4 + q].y)), fmaxf(fabsf(v[i * 4 + q].z), fabsf(v[i * 4 + q].w))));
      }
    mx = wave_maxf(mx);
    const float sc = mx > 0.f ? 224.f / mx : 1.f;
    if (lane == 0) inv_scale[r] = 1.f / sc;
#pragma unroll
    for (int i = 0; i < 2; ++i) {
      uint4 o; o.x = pk4_fp8(v[i * 4 + 0], sc); o.y = pk4_fp8(v[i * 4 + 1], sc); o.z = pk4_fp8(v[i * 4 + 2], sc); o.w = pk4_fp8(v[i * 4 + 3], sc);
      *(uint4*)(dst + (size_t)(i * 8 + (lane >> 3)) * (16384 * 128) + (size_t)r * 128 + (lane & 7) * 16) = o;
    }
  }
}


#define XB_TMO      128
#define XB_XCNT(j)  (256  + 64 * (j))
#define XB_XSUB(j)  (1280 + 64 * (j))
#define XB_XGEN(j)  (2304 + 64 * (j))
#define XB_TOP      3328
#define XB_TOPGEN   3392
#define XCD_BAR_WORDS 3456
#define XB_SPIN_CAP (1u << 22)
#define LAS __attribute__((address_space(3)))
constexpr size_t OFF_BAR = 81 * MBy + 768 * 1024;
__device__ __forceinline__ unsigned xb_ld(unsigned* p)              { return __hip_atomic_load(p, __ATOMIC_RELAXED, __HIP_MEMORY_SCOPE_AGENT); }
__device__ __forceinline__ unsigned xb_add(unsigned* p, unsigned v) { return __hip_atomic_fetch_add(p, v, __ATOMIC_RELAXED, __HIP_MEMORY_SCOPE_AGENT); }
#define XB_SPIN(cond, bar) do { unsigned _sp = 0; while (cond) { __builtin_amdgcn_s_sleep(1); \
    if ((++_sp & 255u) == 0u) { if (xb_ld(&(bar)[XB_TMO])) break; if (_sp > XB_SPIN_CAP) { atomicAdd(&(bar)[XB_TMO], 1u); break; } } } } while (0)
struct XcdBarrier { unsigned* bar; unsigned x; volatile LAS unsigned* st; };
__device__ __forceinline__ XcdBarrier xcd_barrier_post(unsigned* bar, volatile LAS unsigned* st) {
  XcdBarrier b; b.bar = bar; b.x = (unsigned)__builtin_amdgcn_s_getreg((3 << 11) | 20) & 0xFu; b.st = st;
  if (threadIdx.x == 0) (void)xb_add(&bar[XB_XCNT(b.x)], 1u);
  return b;
}
__device__ __forceinline__ void xcd_barrier_complete(unsigned* bar, unsigned x, unsigned& nloc, unsigned& nx) {
  const unsigned G = gridDim.x * gridDim.y * gridDim.z;
  unsigned sum, cnt, mine, sp = 0u;
  for (;;) {
    sum = 0u; cnt = 0u; mine = 0u;
#pragma unroll
    for (unsigned j = 0; j < 16; ++j) { const unsigned c = xb_ld(&bar[XB_XCNT(j)]); sum += c; cnt += (c > 0u) ? 1u : 0u; mine = (j == x) ? c : mine; }
    if (sum == G) break;
    __builtin_amdgcn_s_sleep(1);
    if ((++sp & 255u) == 0u) { if (xb_ld(&bar[XB_TMO])) break; if (sp > XB_SPIN_CAP) { atomicAdd(&bar[XB_TMO], 1u); break; } }
  }
  nloc = mine > 0u ? mine : 1u; nx = cnt > 0u ? cnt : 1u;
}
__device__ __forceinline__ void xcd_barrier(const XcdBarrier& b) {
  asm volatile("s_waitcnt vmcnt(0)" ::: "memory");
  __syncthreads();
  if (threadIdx.x == 0) {
    unsigned* bar = b.bar;
    __builtin_amdgcn_s_waitcnt(0);
    unsigned nloc = b.st[0], nx = b.st[1];
    if (nloc == 0u) { xcd_barrier_complete(bar, b.x, nloc, nx); b.st[0] = nloc; b.st[1] = nx; }
    const unsigned old = xb_add(&bar[XB_XSUB(b.x)], 1u);
    const unsigned gen = old / nloc;
    if (old + 1u == (gen + 1u) * nloc) {
      __builtin_amdgcn_fence(__ATOMIC_RELEASE, "agent");
      asm volatile("s_waitcnt vmcnt(0)" ::: "memory");
      const unsigned og = xb_add(&bar[XB_TOP], 1u);
      const unsigned tg = og / nx;
      if (og + 1u == (tg + 1u) * nx) xb_add(&bar[XB_TOPGEN], 1u);
      else XB_SPIN(xb_ld(&bar[XB_TOPGEN]) == tg, bar);
      __builtin_amdgcn_fence(__ATOMIC_ACQUIRE, "agent");
      xb_add(&bar[XB_XGEN(b.x)], 1u);
      asm volatile("s_waitcnt vmcnt(0)" ::: "memory");
    } else {
      XB_SPIN(xb_ld(&bar[XB_XGEN(b.x)]) == gen, bar);
      __builtin_amdgcn_fence(__ATOMIC_ACQUIRE, "agent");
      asm volatile("s_waitcnt vmcnt(0)" ::: "memory");
    }
  }
  __syncthreads();
}

__device__ __forceinline__ unsigned xcc_id() { return (unsigned)__builtin_amdgcn_s_getreg((3 << 11) | 20) & 0xFu; }
__device__ __forceinline__ void census(const KArgs& a) {
  if (threadIdx.x == 0) {
    unsigned* ctl = (unsigned*)(a.ws + OFF_CTL);
    const unsigned x = xcc_id();
    const unsigned r = atomicAdd(&ctl[x], 1u);
    ctl[16 + blockIdx.x] = (x << 16) | r;
  }
}
struct XInfo { int xi, np, lb, nlb, vb; };
__device__ __forceinline__ XInfo xinfo(const KArgs& a) {
  const unsigned* ctl = (const unsigned*)(a.ws + OFF_CTL);
  const unsigned w = ctl[16 + blockIdx.x]; const int x = (int)(w >> 16), r = (int)(w & 0xffffu);
  XInfo o; o.xi = 0; o.np = 0; o.vb = r;
#pragma unroll
  for (int j = 0; j < 16; ++j) { const int c = (int)ctl[j]; if (c > 0) { o.np++; if (j < x) { o.xi++; o.vb += c; } } }
  o.lb = r; o.nlb = (int)ctl[x];
  return o;
}

template <int BM, int BN, int WM, int WN, class AF, class BF>
__device__ __forceinline__ void mainloop_gen(u16* lds, int K, AF af, BF bf, f32x4 (&acc)[BM / WM / 16][BN / WN / 16]) {
  constexpr int TM = BM / WM / 16, TN = BN / WN / 16;
  constexpr int ACH = BM * 8 / NT, BCH = BN * 8 / NT;
  static_assert(ACH >= 1 && BCH >= 1, "tile too small");
  const int tid = threadIdx.x, lane = tid & 63, wave = tid >> 6;
  const int wm = wave % WM, wn = wave / WM;
  const int l15 = lane & 15, quad = lane >> 4;
  uint4 ra[ACH], rb[BCH];
  const int nk = K / BK;
  auto gload = [&](int k0) {
#pragma unroll
    for (int i = 0; i < ACH; ++i) {
      int c = tid + i * NT; int r = c >> 3, kc = (c & 7) * 8;
      const u16* p = af(r, k0 + kc);
      ra[i] = p ? *(const uint4*)p : make_uint4(0, 0, 0, 0);
    }
#pragma unroll
    for (int i = 0; i < BCH; ++i) {
      int c = tid + i * NT; int r = c >> 3, kc = (c & 7) * 8;
      const u16* p = bf(r, k0 + kc);
      rb[i] = p ? *(const uint4*)p : make_uint4(0, 0, 0, 0);
    }
  };
  auto lstore = [&](int s) {
    u16* sa = lds + s * (BM + BN) * LROW; u16* sb = sa + BM * LROW;
#pragma unroll
    for (int i = 0; i < ACH; ++i) { int c = tid + i * NT; int r = c >> 3, kc = (c & 7) * 8; *(uint4*)(sa + r * LROW + kc) = ra[i]; }
#pragma unroll
    for (int i = 0; i < BCH; ++i) { int c = tid + i * NT; int r = c >> 3, kc = (c & 7) * 8; *(uint4*)(sb + r * LROW + kc) = rb[i]; }
  };
  gload(0); lstore(0); __syncthreads();
  for (int kt = 0; kt < nk; ++kt) {
    if (kt + 1 < nk) gload((kt + 1) * BK);
    const int s = kt & 1;
    const u16* sa = lds + s * (BM + BN) * LROW + (wm * (BM / WM) + l15) * LROW + quad * 8;
    const u16* sb = lds + s * (BM + BN) * LROW + BM * LROW + (wn * (BN / WN) + l15) * LROW + quad * 8;
#pragma unroll
    for (int kk = 0; kk < 2; ++kk) {
      bf16x8 fa[TM], fb[TN];
#pragma unroll
      for (int i = 0; i < TM; ++i) fa[i] = *(const bf16x8*)(sa + i * 16 * LROW + kk * 32);
#pragma unroll
      for (int j = 0; j < TN; ++j) fb[j] = *(const bf16x8*)(sb + j * 16 * LROW + kk * 32);
#pragma unroll
      for (int i = 0; i < TM; ++i)
#pragma unroll
        for (int j = 0; j < TN; ++j) acc[i][j] = __builtin_amdgcn_mfma_f32_16x16x32_bf16(fa[i], fb[j], acc[i][j], 0, 0, 0);
    }
    if (kt + 1 < nk) lstore((kt + 1) & 1);
    __syncthreads();
  }
}
template <int BM, int BN, int WM, int WN, bool SWAP = false, int AKM = 1, class AF, class BF>
__device__ __forceinline__ void mainloop(u16* lds, int K, const u16* __restrict__ abase, AF aoff, const u16* __restrict__ bbase, BF boff, f32x4 (&acc)[BM / WM / 16][BN / WN / 16]) {
  constexpr int TM = BM / WM / 16, TN = BN / WN / 16;
  constexpr int ACH = BM * 8 / NT, BCH = BN * 8 / NT;
  static_assert(ACH >= 1 && BCH >= 1, "tile too small");
  const int tid = threadIdx.x, lane = tid & 63, wave = tid >> 6;
  const int wm = wave % WM, wn = wave / WM;
  const int l15 = lane & 15, quad = lane >> 4;
  u32x4 ra0[ACH], rb0[BCH], ra1[ACH], rb1[BCH];
  unsigned oa[ACH], ob[BCH];
#pragma unroll
  for (int i = 0; i < ACH; ++i) { int c = tid + i * NT; oa[i] = aoff(c >> 3) + (c & 7) * 8 * AKM; }
#pragma unroll
  for (int i = 0; i < BCH; ++i) { int c = tid + i * NT; ob[i] = boff(c >> 3) + (c & 7) * 8; }
  const int nk = K / BK;
#define DEF_STAGE(SFX, RA, RB) \
  auto gload##SFX = [&](int k0) { \
    const u16* ab_ = abase + k0 * AKM; const u16* bb_ = bbase + k0; \
    _Pragma("unroll") for (int i = 0; i < ACH; ++i) RA[i] = *(const u32x4*)(ab_ + oa[i]); \
    _Pragma("unroll") for (int i = 0; i < BCH; ++i) RB[i] = *(const u32x4*)(bb_ + ob[i]); \
  }; \
  auto lstore##SFX = [&](int st) { \
    u16* sa_ = lds + st * (BM + BN) * LROW; u16* sb_ = sa_ + BM * LROW; \
    _Pragma("unroll") for (int i = 0; i < ACH; ++i) { int c = tid + i * NT; int r = c >> 3, kc = (c & 7) * 8; *(u32x4*)(sa_ + r * LROW + kc) = RA[i]; } \
    _Pragma("unroll") for (int i = 0; i < BCH; ++i) { int c = tid + i * NT; int r = c >> 3, kc = (c & 7) * 8; *(u32x4*)(sb_ + r * LROW + kc) = RB[i]; } \
  };
  DEF_STAGE(0, ra0, rb0)
  DEF_STAGE(1, ra1, rb1)
#undef DEF_STAGE
  auto compute = [&](int st) {
    const u16* sa = lds + st * (BM + BN) * LROW + (wm * (BM / WM) + l15) * LROW + quad * 8;
    const u16* sb = lds + st * (BM + BN) * LROW + BM * LROW + (wn * (BN / WN) + l15) * LROW + quad * 8;
#pragma unroll
    for (int kk = 0; kk < 2; ++kk) {
      bf16x8 fa[TM], fb[TN];
#pragma unroll
      for (int i = 0; i < TM; ++i) fa[i] = *(const bf16x8*)(sa + i * 16 * LROW + kk * 32);
#pragma unroll
      for (int j = 0; j < TN; ++j) fb[j] = *(const bf16x8*)(sb + j * 16 * LROW + kk * 32);
#pragma unroll
      for (int i = 0; i < TM; ++i)
#pragma unroll
        for (int j = 0; j < TN; ++j) acc[i][j] = SWAP ? __builtin_amdgcn_mfma_f32_16x16x32_bf16(fb[j], fa[i], acc[i][j], 0, 0, 0) : __builtin_amdgcn_mfma_f32_16x16x32_bf16(fa[i], fb[j], acc[i][j], 0, 0, 0);
    }
  };
  gload0(0);
  gload1(BK);
  lstore0(0);
  lstore1(1);
  __syncthreads();
#pragma unroll 1
  for (int kt = 0; kt < nk; kt += 2) {
    const bool more = kt + 2 < nk;
    if (more) { gload0((kt + 2) * BK); gload1((kt + 3) * BK); }
    compute(0);
    compute(1);
    __syncthreads();
    if (more) { lstore0(0); lstore1(1); }
    __syncthreads();
  }
}
template <int BM, int BN, int WM, int WN, bool SWAP = false, class AF, class BF>
__device__ __forceinline__ void mainloop1(u16* lds, int K, const u16* __restrict__ abase, AF aoff, const u16* __restrict__ bbase, BF boff, f32x4 (&acc)[BM / WM / 16][BN / WN / 16]) {
  constexpr int TM = BM / WM / 16, TN = BN / WN / 16;
  constexpr int ACH = BM * 8 / NT, BCH = BN * 8 / NT;
  static_assert(ACH >= 1 && BCH >= 1, "tile too small");
  const int tid = threadIdx.x, lane = tid & 63, wave = tid >> 6;
  const int wm = wave % WM, wn = wave / WM;
  const int l15 = lane & 15, quad = lane >> 4;
  u32x4 ra0[ACH], rb0[BCH];
  unsigned oa[ACH], ob[BCH];
#pragma unroll
  for (int i = 0; i < ACH; ++i) { int c = tid + i * NT; oa[i] = aoff(c >> 3) + (c & 7) * 8; }
#pragma unroll
  for (int i = 0; i < BCH; ++i) { int c = tid + i * NT; ob[i] = boff(c >> 3) + (c & 7) * 8; }
  const int nk = K / BK;
#define DEF_STAGE(SFX, RA, RB) \
  auto gload##SFX = [&](int k0) { \
    const u16* ab_ = abase + k0; const u16* bb_ = bbase + k0; \
    _Pragma("unroll") for (int i = 0; i < ACH; ++i) RA[i] = *(const u32x4*)(ab_ + oa[i]); \
    _Pragma("unroll") for (int i = 0; i < BCH; ++i) RB[i] = *(const u32x4*)(bb_ + ob[i]); \
  }; \
  auto lstore##SFX = [&](int st) { \
    u16* sa_ = lds + st * (BM + BN) * LROW; u16* sb_ = sa_ + BM * LROW; \
    _Pragma("unroll") for (int i = 0; i < ACH; ++i) { int c = tid + i * NT; int r = c >> 3, kc = (c & 7) * 8; *(u32x4*)(sa_ + r * LROW + kc) = RA[i]; } \
    _Pragma("unroll") for (int i = 0; i < BCH; ++i) { int c = tid + i * NT; int r = c >> 3, kc = (c & 7) * 8; *(u32x4*)(sb_ + r * LROW + kc) = RB[i]; } \
  };
  DEF_STAGE(0, ra0, rb0)
#undef DEF_STAGE
  auto compute = [&](int st) {
    const u16* sa = lds + st * (BM + BN) * LROW + (wm * (BM / WM) + l15) * LROW + quad * 8;
    const u16* sb = lds + st * (BM + BN) * LROW + BM * LROW + (wn * (BN / WN) + l15) * LROW + quad * 8;
#pragma unroll
    for (int kk = 0; kk < 2; ++kk) {
      bf16x8 fa[TM], fb[TN];
#pragma unroll
      for (int i = 0; i < TM; ++i) fa[i] = *(const bf16x8*)(sa + i * 16 * LROW + kk * 32);
#pragma unroll
      for (int j = 0; j < TN; ++j) fb[j] = *(const bf16x8*)(sb + j * 16 * LROW + kk * 32);
#pragma unroll
      for (int i = 0; i < TM; ++i)
#pragma unroll
        for (int j = 0; j < TN; ++j) acc[i][j] = SWAP ? __builtin_amdgcn_mfma_f32_16x16x32_bf16(fb[j], fa[i], acc[i][j], 0, 0, 0) : __builtin_amdgcn_mfma_f32_16x16x32_bf16(fa[i], fb[j], acc[i][j], 0, 0, 0);
    }
  };
  gload0(0);
  lstore0(0);
  __syncthreads();
#pragma unroll 1
  for (int kt = 0; kt < nk; ++kt) {
    const bool more = kt + 1 < nk;
    if (more) gload0((kt + 1) * BK);
    compute(kt & 1);
    if (more) lstore0((kt + 1) & 1);
    __syncthreads();
  }
}
template <int BM, int BN, int WM, int WN>
__device__ __forceinline__ void zero_acc(f32x4 (&acc)[BM / WM / 16][BN / WN / 16]) {
#pragma unroll
  for (int i = 0; i < BM / WM / 16; ++i)
#pragma unroll
    for (int j = 0; j < BN / WN / 16; ++j) acc[i][j] = (f32x4){0.f, 0.f, 0.f, 0.f};
}
template <int BM, int BN, int WM, int WN, class EF>
__device__ __forceinline__ void epilogue(f32x4 (&acc)[BM / WM / 16][BN / WN / 16], int m0, int n0, EF ef) {
  const int lane = threadIdx.x & 63, wave = threadIdx.x >> 6;
  const int wm = wave % WM, wn = wave / WM;
  const int l15 = lane & 15, quad = lane >> 4;
#pragma unroll
  for (int i = 0; i < BM / WM / 16; ++i)
#pragma unroll
    for (int j = 0; j < BN / WN / 16; ++j) ef(m0 + wm * (BM / WM) + i * 16 + quad * 4, n0 + wn * (BN / WN) + j * 16 + l15, acc[i][j]);
}

template <int BM, int BN, int WM, int WN, class EF>
__device__ __forceinline__ void epilogue_t(f32x4 (&acc)[BM / WM / 16][BN / WN / 16], int m0, int n0, EF ef) {
  const int lane = threadIdx.x & 63, wave = threadIdx.x >> 6;
  const int wm = wave % WM, wn = wave / WM;
  const int l15 = lane & 15, quad = lane >> 4;
#pragma unroll
  for (int i = 0; i < BM / WM / 16; ++i)
#pragma unroll
    for (int j = 0; j < BN / WN / 16; ++j) ef(m0 + wm * (BM / WM) + i * 16 + l15, n0 + wn * (BN / WN) + j * 16 + quad * 4, acc[i][j]);
}
__device__ __forceinline__ uint2 pack4(f32x4 v) { uint2 o; o.x = pack2(v[0], v[1]); o.y = pack2(v[2], v[3]); return o; }

template <class CM>
__device__ __forceinline__ void tconv(const float* __restrict__ src, int src_ld, int K, int N, u16* __restrict__ dst, float scale, CM colmap, float* tile) {
  const int tk = K / 64, tn = N / 64;
  for (int t = blockIdx.x; t < tk * tn; t += gridDim.x) {
    const int k0 = (t % tk) * 64, n0 = (t / tk) * 64;
#pragma unroll
    for (int i = 0; i < 8; ++i) {
      int idx = threadIdx.x + i * NT; int kk = idx >> 6, nn = idx & 63; int sc = colmap(n0 + nn);
      tile[kk * 65 + nn] = sc >= 0 ? src[(size_t)(k0 + kk) * src_ld + sc] * scale : 0.f;
    }
    __syncthreads();
#pragma unroll
    for (int i = 0; i < 8; ++i) {
      int idx = threadIdx.x + i * NT; int nn = idx >> 6, kk = idx & 63;
      dst[(size_t)(n0 + nn) * K + k0 + kk] = f2bf(tile[kk * 65 + nn]);
    }
    __syncthreads();
  }
}

__device__ __forceinline__ void rmsnorm_rows(const float* __restrict__ src, const float* __restrict__ g, u16* __restrict__ dst) {
  const int lane = threadIdx.x & 63; const int gw = blockIdx.x * 8 + (threadIdx.x >> 6); const int nw = gridDim.x * 8;
  for (int r = gw; r < T; r += nw) {
    const float4* p = (const float4*)(src + (size_t)r * D);
    float4 v[8]; float ss = 0.f;
#pragma unroll
    for (int i = 0; i < 8; ++i) { const f32x4 t4 = __builtin_nontemporal_load((const f32x4*)p + lane + i * 64); v[i] = make_float4(t4[0], t4[1], t4[2], t4[3]); ss += v[i].x * v[i].x + v[i].y * v[i].y + v[i].z * v[i].z + v[i].w * v[i].w; }
    ss = wave_sum(ss);
    const float rs = rsqrtf(ss * (1.f / D) + 1e-6f);
#pragma unroll
    for (int i = 0; i < 8; ++i) {
      float4 gg = ((const float4*)g)[lane + i * 64];
      uint2 o; o.x = pack2(v[i].x * rs * gg.x, v[i].y * rs * gg.y); o.y = pack2(v[i].z * rs * gg.z, v[i].w * rs * gg.w);
      ((uint2*)(dst + (size_t)r * D))[lane + i * 64] = o;
    }
  }
}

__device__ __forceinline__ void convert_flat(const float* __restrict__ src, u16* __restrict__ dst, size_t n8) {
  for (size_t i = (size_t)blockIdx.x * NT + threadIdx.x; i < n8; i += (size_t)gridDim.x * NT) {
    float4 a = ((const float4*)src)[2 * i], b = ((const float4*)src)[2 * i + 1];
    uint4 o; o.x = pack2(a.x, a.y); o.y = pack2(a.z, a.w); o.z = pack2(b.x, b.y); o.w = pack2(b.z, b.w);
    ((uint4*)dst)[i] = o;
  }
}

__device__ void s5_build(const KArgs& a, float* sm) {
  float* aT = sm; float* aT1 = sm + 128; float* coef = sm + 256; float* Bb = sm + 384;
  const float* lam_re = a.in[3]; const float* lam_im = a.in[4]; const float* log_dt = a.in[5];
  const float* b_re = a.in[6]; const float* b_im = a.in[7]; const float* c_re = a.in[8]; const float* c_im = a.in[9];
  u16* Kmat = (u16*)(a.ws + OFF_KMAT); u16* Emat = (u16*)(a.ws + OFF_EMAT); u16* Mmat = (u16*)(a.ws + OFF_MMAT);
  float* aL = (float*)(a.ws + OFF_AL);
  const int tid = threadIdx.x;
  for (int item = blockIdx.x; item < 32 * 64; item += gridDim.x) {
    const int g = item >> 6, tau = item & 63;
    if (tid < 64) {
      const int p = tid;
      const float lr = lam_re[g * 64 + p], li = lam_im[g * 64 + p], dt = expf(log_dt[g]);
      const double wr = (double)lr * (double)dt, wi = (double)li * (double)dt;
      const double twopi = 6.283185307179586476925;
      auto cpow = [&](int n, float& re, float& im) {
        double th = wi * n; th -= twopi * rint(th / twopi);
        float mag = expf((float)(wr * n)); float s, c; s = sinf((float)th); c = cosf((float)th);
        re = mag * c; im = mag * s;
      };
      float ar, ai; cpow(1, ar, ai);
      float nr = ar - 1.f, ni = ai; float inv = 1.f / (lr * lr + li * li);
      coef[2 * p] = (nr * lr + ni * li) * inv; coef[2 * p + 1] = (ni * lr - nr * li) * inv;
      float r0, i0, r1, i1; cpow(tau, r0, i0); cpow(tau + 1, r1, i1);
      aT[2 * p] = r0; aT[2 * p + 1] = i0; aT1[2 * p] = r1; aT1[2 * p + 1] = i1;
      if (tau == 63) { aL[(g * 64 + p) * 2] = r1; aL[(g * 64 + p) * 2 + 1] = i1; }
    }
    __syncthreads();
    for (int idx = tid; idx < 1024; idx += NT) {
      const int p = idx >> 4;
      const float br = b_re[g * 1024 + idx], bi = b_im[g * 1024 + idx];
      const float cr = coef[2 * p], ci = coef[2 * p + 1];
      Bb[2 * idx] = cr * br - ci * bi; Bb[2 * idx + 1] = cr * bi + ci * br;
    }
    __syncthreads();
    if (tid < 256) {
      const int h = tid >> 4, h2 = tid & 15; float s = 0.f;
      for (int p = 0; p < 64; ++p) {
        const float cr = c_re[g * 1024 + h * 64 + p], ci = c_im[g * 1024 + h * 64 + p];
        const float car = cr * aT[2 * p] - ci * aT[2 * p + 1], cai = cr * aT[2 * p + 1] + ci * aT[2 * p];
        s += car * Bb[2 * (p * 16 + h2)] - cai * Bb[2 * (p * 16 + h2) + 1];
      }
      Kmat[((size_t)(g * 64 + tau) * 16 + h) * 16 + h2] = f2bf(s);
    }
    for (int idx = tid; idx < 1024; idx += NT) {
      {
        const int h = idx >> 6, p = idx & 63;
        const float cr = c_re[g * 1024 + idx], ci = c_im[g * 1024 + idx];
        const float car = cr * aT1[2 * p] - ci * aT1[2 * p + 1], cai = cr * aT1[2 * p + 1] + ci * aT1[2 * p];
        const size_t base = ((size_t)g * 1024 + tau * 16 + h) * 128;
        Emat[base + p] = f2bf(car); Emat[base + 64 + p] = f2bf(-cai);
      }
      {
        const int p = idx >> 4, h2 = idx & 15; const int s = 63 - tau;
        const float br = Bb[2 * idx], bi = Bb[2 * idx + 1];
        const float mr = aT[2 * p] * br - aT[2 * p + 1] * bi, mi = aT[2 * p] * bi + aT[2 * p + 1] * br;
        Mmat[((size_t)g * 128 + p) * 1024 + s * 16 + h2] = f2bf(mr);
        Mmat[((size_t)g * 128 + 64 + p) * 1024 + s * 16 + h2] = f2bf(mi);
      }
    }
    __syncthreads();
  }
}

__device__ __forceinline__ void phase0(const KArgs& a, unsigned char* ldsb) {
  float* tile = (float*)ldsb;
  if (blockIdx.x == 0) {
    if (threadIdx.x < 16) ((unsigned*)(a.ws + OFF_CTL))[threadIdx.x] = 0u;
    for (int i = threadIdx.x; i < XCD_BAR_WORDS; i += NT) ((unsigned*)(a.ws + OFF_BAR))[i] = 0u;
  }
  auto ident = [](int n) { return n; };
  tconv(a.in[2], 7688, 2048, 7808, (u16*)(a.ws + OFF_WIN), 1.f,
        [](int n) { return n < 3584 ? n : (n < 7680 ? n + 8 : (n < 7688 ? n - 7680 + 3584 : -1)); }, tile);
  tconv(a.in[11], 4096, 512, 4096, (u16*)(a.ws + OFF_WGLU), 1.f, ident, tile);
  for (int h = 0; h < 4; ++h) {
    tconv(a.in[14] + h * 147456, 384, 384, 384, (u16*)(a.ws + OFF_WQ) + h * 147456, 1.f, ident, tile);
    tconv(a.in[15] + h * 147456, 384, 384, 384, (u16*)(a.ws + OFF_WK) + h * 147456, 0.05103103630798288f, ident, tile);
    tconv(a.in[16] + h * 147456, 384, 384, 384, (u16*)(a.ws + OFF_WV) + h * 147456, 1.f, ident, tile);
  }
  tconv(a.in[21], 2048, 1536, 2048, (u16*)(a.ws + OFF_WMO), 1.f, ident, tile);
  tconv(a.in[22], 2048, 2048, 2048, (u16*)(a.ws + OFF_WOUT), 1.f, ident, tile);
  tconv(a.in[24], 2048, 2048, 2048, (u16*)(a.ws + OFF_WQRY), 1.f, ident, tile);
  convert_flat(a.in[25], (u16*)(a.ws + OFF_KEY1), 8 * 128 * 128 / 8);
  convert_flat(a.in[26], (u16*)(a.ws + OFF_KEY2), 8 * 128 * 128 / 8);
  s5_build(a, tile);
  rmsnorm_rows(a.in[0], a.in[1], (u16*)(a.ws + OFF_R1));
}

__device__ __forceinline__ void phase1(const KArgs& a, u16* lds) {
  const u16* hn = (const u16*)(a.ws + OFF_R1); const u16* W = (const u16*)(a.ws + OFF_WIN);
  u16* Up = (u16*)(a.ws + OFF_R6); u16* xm = (u16*)(a.ws + OFF_R2); u16* sz = (u16*)(a.ws + OFF_R3);
  u16* sga = (u16*)(a.ws + OFF_R4); u16* sgb = (u16*)(a.ws + OFF_R5); float* gif = (float*)(a.ws + OFF_GIF);
  constexpr int NTN = 30, NTILES = 128 * NTN;
  for (int t = blockIdx.x; t < NTILES; t += gridDim.x) {
    const int mg = t / (32 * NTN), rem = t % (32 * NTN); const int nt = rem / 32, mt = mg * 32 + rem % 32;
    const int m0 = mt * 256, n0 = nt * 256;
    f32x4 acc[4][8]; zero_acc<256, 256, 4, 2>(acc);
    mainloop1<256, 256, 4, 2, true>(lds, 2048, hn, [&](int r) { return (unsigned)(m0 + r) * 2048u; }, W, [&](int c) { return (unsigned)(n0 + c) * 2048u; }, acc);
    if (n0 < 512) {
      epilogue_t<256, 256, 4, 2>(acc, m0, n0, [&](int row, int col, f32x4 v) {
        const int g = col >> 4, hh = col & 15;
        *(uint2*)(Up + (size_t)g * 524288 + (size_t)(row >> 6) * 1024 + (row & 63) * 16 + hh) = pack4(v);
      });
    } else if (n0 < 2048) {
      epilogue_t<256, 256, 4, 2>(acc, m0, n0, [&](int row, int col, f32x4 v) { *(uint2*)(xm + (size_t)row * 1536 + col - 512) = pack4(v); });
    } else if (n0 < 3584) {
      epilogue_t<256, 256, 4, 2>(acc, m0, n0, [&](int row, int col, f32x4 v) {
        *(uint2*)(sz + (size_t)row * 1536 + col - 2048) = pack4((f32x4){sigm(v[0]), sigm(v[1]), sigm(v[2]), sigm(v[3])});
      });
    } else {
      u16* dst = n0 < 5632 ? sga : sgb; const int cb = n0 < 5632 ? 3584 : 5632;
      epilogue_t<256, 256, 4, 2>(acc, m0, n0, [&](int row, int col, f32x4 v) {
        *(uint2*)(dst + (size_t)row * 2048 + col - cb) = pack4((f32x4){sigm(v[0]), sigm(v[1]), sigm(v[2]), sigm(v[3])});
      });
    }
  }
  {
    const int lane = threadIdx.x & 63, l15 = lane & 15, quad = lane >> 4; const int gw = blockIdx.x * 8 + (threadIdx.x >> 6); const int nw = gridDim.x * 8;
    for (int rt = gw; rt < T / 16; rt += nw) {
      f32x4 acc = (f32x4){0.f, 0.f, 0.f, 0.f};
      const u16* ap = hn + (size_t)(rt * 16 + l15) * 2048 + quad * 8;
      const u16* bp = W + (size_t)(7680 + l15) * 2048 + quad * 8;
#pragma unroll 8
      for (int ks = 0; ks < 64; ++ks) {
        const bf16x8 fa = *(const bf16x8*)(ap + ks * 32), fb = *(const bf16x8*)(bp + ks * 32);
        acc = __builtin_amdgcn_mfma_f32_16x16x32_bf16(fa, fb, acc, 0, 0, 0);
      }
      if (l15 < 8) {
#pragma unroll
        for (int r = 0; r < 4; ++r) gif[(size_t)(rt * 16 + quad * 4 + r) * 8 + l15] = acc[r];
      }
    }
  }
}

__device__ __forceinline__ void phase2(const KArgs& a, u16* lds) {
  const int tid = threadIdx.x, lane = tid & 63, wave = tid >> 6;
  {
    const int gw = blockIdx.x * 8 + wave;
    if (gw < 64) {
      const int bh = gw, b = bh >> 2, h = bh & 3;
      const float* gif = (const float*)(a.ws + OFF_GIF);
      float* gG = (float*)(a.ws + OFF_GATES); float* gM = gG + T * 4; float* gInter = gM + T * 4; float* gEinv = gInter + T * 4;
      float* gWend = gEinv + T * 4; float* gDecay = gWend + T * 4;
      const float bi = a.in[17][h], bfv = a.in[18][h];
      float iv[32], fv[32];
#pragma unroll
      for (int c = 0; c < 32; ++c) { const size_t tok = (size_t)b * 2048 + c * 64 + lane; iv[c] = gif[tok * 8 + h]; fv[c] = gif[tok * 8 + 4 + h]; }
      float m_prev = 0.f;
#pragma unroll
      for (int c = 0; c < 32; ++c) {
        const float ii = iv[c] + bi, ff = fv[c] + bfv;
        const float lf = fminf(ff, 0.f) - log1pf(expf(-fabsf(ff)));
        float bc = lf;
#pragma unroll
        for (int o = 1; o < 64; o <<= 1) { float t2 = __shfl_up(bc, o); if (lane >= o) bc += t2; }
        const float g = ii - bc;
        float cm = g;
#pragma unroll
        for (int o = 1; o < 64; o <<= 1) { float t2 = __shfl_up(cm, o); if (lane >= o) cm = fmaxf(cm, t2); }
        const float M = fmaxf(m_prev, cm);
        const float ML = __shfl(M, 63), bl = __shfl(bc, 63);
        const size_t gi = (size_t)bh * 2048 + c * 64 + lane;
        gG[gi] = g; gM[gi] = M; gInter[gi] = expf(m_prev - M); gEinv[gi] = expf(-bc - M); gWend[gi] = expf(g - ML);
        if (lane == 0) gDecay[bh * 32 + c] = expf(m_prev - ML);
        m_prev = bl + ML;
      }
    }
  }
  {
    const u16* Up = (const u16*)(a.ws + OFF_R6); const u16* Mm = (const u16*)(a.ws + OFF_MMAT); float* V5 = (float*)(a.ws + OFF_V5);
    for (int t = blockIdx.x; t < 256; t += gridDim.x) {
      const int g = t >> 3, m0 = (t & 7) * 64;
      f32x4 acc[2][2]; zero_acc<64, 128, 2, 4>(acc);
      mainloop<64, 128, 2, 4>(lds, 1024, Up + (size_t)g * 524288, [&](int r) { return (unsigned)(m0 + r) * 1024u; }, Mm + (size_t)g * 131072, [&](int c) { return (unsigned)c * 1024u; }, acc);
      epilogue<64, 128, 2, 4>(acc, m0, 0, [&](int row, int col, f32x4 v) {
#pragma unroll
        for (int r = 0; r < 4; ++r) V5[((size_t)g * 512 + row + r) * 128 + col] = v[r];
      });
    }
  }
  {
    const u16* xm = (const u16*)(a.ws + OFF_R2); const u16* Wv = (const u16*)(a.ws + OFF_WV); u16* VT = (u16*)(a.ws + OFF_R7);
    for (int t = blockIdx.x; t < 1536; t += gridDim.x) {
      const int nt = t % 3, mt = (t / 3) % 128, h = t / 384;
      const int m0 = mt * 256, n0 = nt * 128;
      f32x4 acc[4][4]; zero_acc<256, 128, 4, 2>(acc);
      mainloop<256, 128, 4, 2>(lds, 384, xm + h * 384, [&](int r) { return (unsigned)(m0 + r) * 1536u; }, Wv + (size_t)(h * 384 + n0) * 384, [&](int c) { return (unsigned)c * 384u; }, acc);
      epilogue<256, 128, 4, 2>(acc, m0, n0, [&](int row, int col, f32x4 v) {
        const int b = row >> 11, c = (row >> 6) & 31, s = row & 63; const int cid = (b * 4 + h) * 32 + c;
        uint2 o; o.x = pack2(v[0], v[1]); o.y = pack2(v[2], v[3]);
        *(uint2*)(VT + ((((size_t)cid * 24 + (col >> 4)) * 2 + (s >> 5)) * 64 + (((s & 31) >> 3) * 16 + (col & 15))) * 8 + (s & 7)) = o;
      });
    }
  }
  {
    const u16* xm = (const u16*)(a.ws + OFF_R2); u16* xc = (u16*)(a.ws + OFF_R1);
    const float* cw = a.in[12]; const float* cb = a.in[13];
    const size_t n8 = (size_t)T * 192;
    for (size_t i = (size_t)blockIdx.x * NT + tid; i < n8; i += (size_t)gridDim.x * NT) {
      const int tok = (int)(i / 192), c8 = (int)(i % 192) * 8; const int s = tok & 2047;
      float o[8];
#pragma unroll
      for (int q = 0; q < 8; ++q) o[q] = cb[c8 + q];
#pragma unroll
      for (int j = 0; j < 4; ++j) {
        if (s - 3 + j >= 0) {
          uint4 v = *(const uint4*)(xm + (size_t)(tok - 3 + j) * 1536 + c8);
          const float* w = cw + j * 1536 + c8;
          o[0] += bflo(v.x) * w[0]; o[1] += bfhi(v.x) * w[1]; o[2] += bflo(v.y) * w[2]; o[3] += bfhi(v.y) * w[3];
          o[4] += bflo(v.z) * w[4]; o[5] += bfhi(v.z) * w[5]; o[6] += bflo(v.w) * w[6]; o[7] += bfhi(v.w) * w[7];
        }
      }
#pragma unroll
      for (int q = 0; q < 8; ++q) o[q] = o[q] * sigm(o[q]);
      uint4 r; r.x = pack2(o[0], o[1]); r.y = pack2(o[2], o[3]); r.z = pack2(o[4], o[5]); r.w = pack2(o[6], o[7]);
      *(uint4*)(xc + (size_t)tok * 1536 + c8) = r;
    }
  }
}

__device__ __forceinline__ void phase3(const KArgs& a, u16* lds) {
  const int tid = threadIdx.x;
  {
    const float* V5 = (const float*)(a.ws + OFF_V5); u16* X5 = (u16*)(a.ws + OFF_X5); const float* aL = (const float*)(a.ws + OFF_AL);
    for (int i = blockIdx.x * NT + tid; i < 32768; i += gridDim.x * NT) {
      const int p = i & 63, b = (i >> 6) & 15, g = i >> 10;
      const float lr = aL[(g * 64 + p) * 2], li = aL[(g * 64 + p) * 2 + 1];
      float xr = 0.f, xi = 0.f;
      for (int c = 0; c < 32; ++c) {
        const size_t idx = ((size_t)g * 512 + b * 32 + c) * 128;
        X5[idx + p] = f2bf(xr); X5[idx + 64 + p] = f2bf(xi);
        const float vr = V5[idx + p], vi = V5[idx + 64 + p];
        const float nr = lr * xr - li * xi + vr, ni = lr * xi + li * xr + vi;
        xr = nr; xi = ni;
      }
    }
  }
  {
    const u16* xc = (const u16*)(a.ws + OFF_R1);
    u16* Kn = (u16*)(a.ws + OFF_R2); u16* KT = (u16*)(a.ws + OFF_R9); u16* QF = (u16*)a.out;
    const u16* Wq = (const u16*)(a.ws + OFF_WQ);
    for (int t = blockIdx.x; t < 1536; t += gridDim.x) {
      const int nt = t % 3, mt = (t / 3) % 128, h = t / 384;
      const int m0 = mt * 256, n0 = nt * 256;
      f32x4 acc[4][8]; zero_acc<256, 256, 4, 2>(acc);
      mainloop1<256, 256, 4, 2>(lds, 384, xc + h * 384, [&](int r) { return (unsigned)(m0 + r) * 1536u; }, Wq,
          [&](int c) { const int col = n0 + c; return col < 384 ? (unsigned)(h * 384 + col) * 384u : 1048576u + (unsigned)(h * 384 + col - 384) * 384u; }, acc);
      epilogue<256, 256, 4, 2>(acc, m0, n0, [&](int row, int col768, f32x4 v) {
        if (col768 < 384) {
          const int col = col768;
#pragma unroll
          for (int r = 0; r < 4; ++r) {
            const u16 q16 = f2bf(v[r]); const int tk = row + r;
            const int b = tk >> 11, c = (tk >> 6) & 31, s = tk & 63; const int cid = (b * 4 + h) * 32 + c;
            QF[((((size_t)cid * 4 + (s >> 4)) * 12 + (col >> 5)) * 64 + (((col & 31) >> 3) * 16 + (s & 15))) * 8 + (col & 7)] = q16;
          }
        } else {
          const int col = col768 - 384;
#pragma unroll
          for (int r = 0; r < 4; ++r) Kn[(size_t)(row + r) * 1536 + h * 384 + col] = f2bf(v[r]);
          const int b = row >> 11, c = (row >> 6) & 31, s = row & 63; const int cid = (b * 4 + h) * 32 + c;
          uint2 o; o.x = pack2(v[0], v[1]); o.y = pack2(v[2], v[3]);
          *(uint2*)(KT + ((((size_t)cid * 24 + (col >> 4)) * 2 + (s >> 5)) * 64 + (((s & 31) >> 3) * 16 + (col & 15))) * 8 + (s & 7)) = o;
        }
      });
    }
  }
}

__device__ __forceinline__ void phase4(const KArgs& a, u16* lds) {
  const int tid = threadIdx.x, lane = tid & 63;
  {
    const u16* QF = (const u16*)a.out; const u16* Kn = (const u16*)(a.ws + OFF_R2); u16* SW = (u16*)(a.ws + OFF_R10);
    const float* gG = (const float*)(a.ws + OFF_GATES); const float* gM = gG + T * 4; float* gDen = (float*)(a.ws + OFF_GATES) + (size_t)T * 4 * 5 + 4096;
    float* dl = (float*)((unsigned char*)lds + GEMM_LDS);
    for (int cid = blockIdx.x; cid < 2048; cid += gridDim.x) {
      const int bh = cid >> 5, c = cid & 31, b = bh >> 2, h = bh & 3;
      const int t0 = b * 2048 + c * 64; const size_t gi = (size_t)bh * 2048 + c * 64;
      if (tid < 64) dl[tid] = 0.f;
      f32x4 acc[1][2]; zero_acc<64, 64, 4, 2>(acc);
      mainloop<64, 64, 4, 2, false, 16>(lds, 384, QF + (size_t)cid * 24576, [&](int r) { return (unsigned)(((r >> 4) * 768 + (r & 15)) * 8); }, Kn + (size_t)t0 * 1536 + h * 384, [&](int cc) { return (unsigned)cc * 1536u; }, acc);
      float ps[4] = {0.f, 0.f, 0.f, 0.f}; int prow = 0;
      epilogue<64, 64, 4, 2>(acc, 0, 0, [&](int row, int col, f32x4 v) {
        const float gs = gG[gi + col]; prow = row;
#pragma unroll
        for (int r = 0; r < 4; ++r) {
          const int tt = row + r;
          const float w = (col <= tt) ? v[r] * __expf(gs - gM[gi + tt]) : 0.f;
          SW[((((size_t)cid * 4 + (tt >> 4)) * 2 + (col >> 5)) * 64 + (((col & 31) >> 3) * 16 + (tt & 15))) * 8 + (col & 7)] = f2bf(w);
          ps[r] += w;
        }
      });
#pragma unroll
      for (int r = 0; r < 4; ++r) {
        float s = ps[r];
        s += __shfl_xor(s, 1); s += __shfl_xor(s, 2); s += __shfl_xor(s, 4); s += __shfl_xor(s, 8);
        if ((lane & 15) == 0) atomicAdd(&dl[prow + r], s);
      }
      __syncthreads();
      if (tid < 64) gDen[gi + tid] = dl[tid];
    }
  }
  {
    const u16* Up = (const u16*)(a.ws + OFF_R6); const u16* Km = (const u16*)(a.ws + OFF_KMAT); const u16* Em = (const u16*)(a.ws + OFF_EMAT);
    const u16* X5 = (const u16*)(a.ws + OFF_X5); u16* Yg = (u16*)(a.ws + OFF_R1 + 96 * MBy); const float* dsk = a.in[10];
    for (int t = blockIdx.x; t < 512; t += gridDim.x) {
      const int nt = t & 7, mt = (t >> 3) & 1, g = t >> 4;
      const int m0 = mt * 256, n0 = nt * 128;
      f32x4 acc[4][4]; zero_acc<256, 128, 4, 2>(acc);
      mainloop_gen<256, 128, 4, 2>(lds, n0 + 128,
          [&](int r, int k) { return Up + (size_t)g * 524288 + (size_t)(m0 + r) * 1024 + k; },
          [&](int c, int k) -> const u16* {
            const int n = n0 + c; const int j = n >> 4, hh = n & 15, s = k >> 4, h0 = k & 15;
            return s <= j ? Km + ((size_t)(g * 64 + (j - s)) * 16 + hh) * 16 + h0 : (const u16*)nullptr;
          }, acc);
      mainloop<256, 128, 4, 2>(lds, 128, X5 + ((size_t)g * 512 + m0) * 128, [&](int r) { return (unsigned)r * 128u; }, Em + ((size_t)g * 1024 + n0) * 128, [&](int c) { return (unsigned)c * 128u; }, acc);
      epilogue<256, 128, 4, 2>(acc, m0, n0, [&](int row, int col, f32x4 v) {
        const int j = col >> 4, hh = col & 15, ch = g * 16 + hh; const float dk = dsk[ch];
#pragma unroll
        for (int r = 0; r < 4; ++r) {
          const int rr = row + r;
          const float u = bf2f(Up[(size_t)g * 524288 + (size_t)rr * 1024 + j * 16 + hh]);
          Yg[((size_t)rr * 64 + j) * 512 + ch] = f2bf(gelu_t(v[r] + dk * u));
        }
      });
    }
  }
}

__device__ __forceinline__ void phase5(const KArgs& a, u16* lds) {
  const int tid = threadIdx.x, lane = tid & 63, wave = tid >> 6, l15 = lane & 15, quad = lane >> 4;
  const int dq = wave & 3, eh = wave >> 2;
  u16* Cl = lds; float* nl = (float*)(lds + 96 * 392); unsigned* pfl = (unsigned*)(lds + 96 * 392) + 1024;
  const u16* QF = (const u16*)a.out; const u16* KTF = (const u16*)(a.ws + OFF_R9); const u16* VTF = (const u16*)(a.ws + OFF_R7);
  const u16* SWF = (const u16*)(a.ws + OFF_R10); u16* hraw = (u16*)(a.ws + OFF_R2);
  const float* gG = (const float*)(a.ws + OFF_GATES); const float* gInter = gG + (size_t)T * 8; const float* gEinv = gG + (size_t)T * 12;
  const float* gWend = gG + (size_t)T * 16; const float* gDecay = gG + (size_t)T * 20; const float* gDen = gG + (size_t)T * 20 + 4096;
  for (int unit = blockIdx.x; unit < 256; unit += gridDim.x) {
    const int bh = gridDim.x == 256 ? (unit & 7) + 8 * (unit >> 5) : unit >> 2, j = gridDim.x == 256 ? (unit >> 3) & 3 : unit & 3, b = bh >> 2, h = bh & 3;
    f32x4 Ct[6][4];
#pragma unroll
    for (int di = 0; di < 6; ++di)
#pragma unroll
      for (int ei = 0; ei < 4; ++ei) Ct[di][ei] = (f32x4){0.f, 0.f, 0.f, 0.f};
    unsigned pf = 0u;
    for (int c = 0; c < 32; ++c) {
      const int cid = bh * 32 + c, t0 = b * 2048 + c * 64; const size_t gi = (size_t)bh * 2048 + c * 64;
      pfl[tid] = pf;
#pragma unroll
      for (int di = 0; di < 6; ++di) {
#pragma unroll
        for (int ei = 0; ei < 3; ++ei) {
          const int e = eh * 48 + ei * 16 + l15, d = dq * 96 + di * 16 + quad * 4;
          uint2 o; o.x = pack2(Ct[di][ei][0], Ct[di][ei][1]); o.y = pack2(Ct[di][ei][2], Ct[di][ei][3]);
          *(uint2*)(Cl + e * 392 + d) = o;
        }
        if (eh == 0 && l15 == 0) *(f32x4*)(nl + dq * 96 + di * 16 + quad * 4) = Ct[di][3];
      }
      asm volatile("s_waitcnt lgkmcnt(0)\n\ts_barrier" ::: "memory");
      const int tt = wave & 3, eg = wave >> 2;
      f32x4 aqc[3], asv[3];
#pragma unroll
      for (int ej = 0; ej < 3; ++ej) { aqc[ej] = (f32x4){0.f, 0.f, 0.f, 0.f}; asv[ej] = (f32x4){0.f, 0.f, 0.f, 0.f}; }
      float qnp = 0.f;
      {
        const u16* qf = QF + ((size_t)(cid * 4 + tt) * 12) * 512 + lane * 8;
#pragma unroll 2
        for (int ks = 0; ks < 12; ++ks) {
          const bf16x8 fa = *(const bf16x8*)(qf + ks * 512);
#pragma unroll
          for (int ej = 0; ej < 3; ++ej) {
            const bf16x8 fb = *(const bf16x8*)(Cl + (eg * 48 + ej * 16 + l15) * 392 + ks * 32 + quad * 8);
            aqc[ej] = __builtin_amdgcn_mfma_f32_16x16x32_bf16(fa, fb, aqc[ej], 0, 0, 0);
          }
          const f32x4 n0 = *(const f32x4*)(nl + ks * 32 + quad * 8), n1 = *(const f32x4*)(nl + ks * 32 + quad * 8 + 4);
#pragma unroll
          for (int i = 0; i < 4; ++i) qnp += bf2f((u16)fa[i]) * n0[i] + bf2f((u16)fa[4 + i]) * n1[i];
        }
        qnp += __shfl_xor(qnp, 16); qnp += __shfl_xor(qnp, 32);
        const u16* swf = SWF + ((size_t)(cid * 4 + tt) * 2) * 512 + lane * 8;
#pragma unroll
        for (int ks = 0; ks < 2; ++ks) {
          const bf16x8 fa = *(const bf16x8*)(swf + ks * 512);
#pragma unroll
          for (int ej = 0; ej < 3; ++ej) {
            const bf16x8 fb = *(const bf16x8*)(VTF + (((size_t)cid * 24 + (j * 6 + eg * 3 + ej)) * 2 + ks) * 512 + lane * 8);
            asv[ej] = __builtin_amdgcn_mfma_f32_16x16x32_bf16(fa, fb, asv[ej], 0, 0, 0);
          }
        }
#pragma unroll
        for (int r = 0; r < 4; ++r) {
          const int t = tt * 16 + quad * 4 + r;
          const float qn = __shfl(qnp, quad * 4 + r);
          const float inter = gInter[gi + t];
          const float dn = gDen[gi + t] + inter * qn;
          const float inv = 1.f / fmaxf(fabsf(dn), gEinv[gi + t]);
#pragma unroll
          for (int ej = 0; ej < 3; ++ej)
            hraw[(size_t)(t0 + t) * 1536 + h * 384 + j * 96 + eg * 48 + ej * 16 + l15] = f2bf((asv[ej][r] + inter * aqc[ej][r]) * inv);
        }
      }
      const float decay = gDecay[cid];
      asm volatile("s_waitcnt lgkmcnt(0)\n\ts_barrier" ::: "memory");
      pf = 0u;
      if (c + 1 < 32) {
        const int nc = cid + 1;
        if (tid < 384) { pf ^= *(const unsigned*)(QF + (size_t)nc * 24576 + tid * 64); pf ^= *(const unsigned*)(KTF + (size_t)nc * 24576 + tid * 64); }
        if (tid < 96) pf ^= *(const unsigned*)(VTF + ((size_t)nc * 24 + j * 6) * 1024 + tid * 64);
        if (tid < 64) pf ^= *(const unsigned*)(SWF + (size_t)nc * 4096 + tid * 64);
      }
#pragma unroll
      for (int di = 0; di < 6; ++di)
#pragma unroll
        for (int ei = 0; ei < 4; ++ei) Ct[di][ei] *= decay;
#pragma unroll
      for (int ks = 0; ks < 2; ++ks) {
        const float* wp = gWend + gi + ks * 32 + quad * 8;
        const float4 w0 = *(const float4*)wp, w1 = *(const float4*)(wp + 4);
        bf16x8 fb[4];
#pragma unroll
        for (int ei = 0; ei < 3; ++ei) {
          const uint4 v = *(const uint4*)(VTF + (((size_t)cid * 24 + (j * 6 + eh * 3 + ei)) * 2 + ks) * 512 + lane * 8);
          uint4 o;
          o.x = pack2(bflo(v.x) * w0.x, bfhi(v.x) * w0.y); o.y = pack2(bflo(v.y) * w0.z, bfhi(v.y) * w0.w);
          o.z = pack2(bflo(v.z) * w1.x, bfhi(v.z) * w1.y); o.w = pack2(bflo(v.w) * w1.z, bfhi(v.w) * w1.w);
          fb[ei] = *(bf16x8*)&o;
        }
        {
          uint4 o = make_uint4(0, 0, 0, 0);
          if (l15 == 0) { o.x = pack2(w0.x, w0.y); o.y = pack2(w0.z, w0.w); o.z = pack2(w1.x, w1.y); o.w = pack2(w1.z, w1.w); }
          fb[3] = *(bf16x8*)&o;
        }
#pragma unroll
        for (int di = 0; di < 6; ++di) {
          const bf16x8 fa = *(const bf16x8*)(KTF + (((size_t)cid * 24 + (dq * 6 + di)) * 2 + ks) * 512 + lane * 8);
#pragma unroll
          for (int ei = 0; ei < 3; ++ei) Ct[di][ei] = __builtin_amdgcn_mfma_f32_16x16x32_bf16(fa, fb[ei], Ct[di][ei], 0, 0, 0);
          if (eh == 0) Ct[di][3] = __builtin_amdgcn_mfma_f32_16x16x32_bf16(fa, fb[3], Ct[di][3], 0, 0, 0);
        }
      }
    }
    __syncthreads();
  }
}

__device__ __forceinline__ void phase6(const KArgs& a) {
  const int lane = threadIdx.x & 63; const int gw = blockIdx.x * 8 + (threadIdx.x >> 6); const int nw = gridDim.x * 8;
  const u16* hraw = (const u16*)(a.ws + OFF_R2); const u16* sz = (const u16*)(a.ws + OFF_R3); const u16* xc = (const u16*)(a.ws + OFF_R1);
  u16* Hn = (u16*)(a.ws + OFF_R7); const float* gain = a.in[19]; const float* skip = a.in[20];
  for (int it = gw; it < T * 4; it += nw) {
    const int tok = it >> 2, h = it & 3; const size_t base = (size_t)tok * 1536 + h * 384;
    float v[6]; float s = 0.f;
#pragma unroll
    for (int i = 0; i < 6; ++i) { v[i] = bf2f(hraw[base + lane + i * 64]) * bf2f(sz[base + lane + i * 64]); s += v[i]; }
    const float mu = wave_sum(s) * (1.f / 384.f);
    float q = 0.f;
#pragma unroll
    for (int i = 0; i < 6; ++i) { v[i] -= mu; q += v[i] * v[i]; }
    const float rs = rsqrtf(wave_sum(q) * (1.f / 384.f) + 1e-6f);
#pragma unroll
    for (int i = 0; i < 6; ++i) {
      const int e = h * 384 + lane + i * 64;
      Hn[base + lane + i * 64] = f2bf(v[i] * rs * gain[e] + skip[e] * bf2f(xc[base + lane + i * 64]));
    }
  }
}

__device__ __forceinline__ void phase7a(const KArgs& a, u16* lds) {
  const u16* Yg = (const u16*)(a.ws + OFF_R1 + 96 * MBy); const u16* Wg = (const u16*)(a.ws + OFF_WGLU);
  const u16* sga = (const u16*)(a.ws + OFF_R4); u16* ya = (u16*)a.out;
  for (int t = blockIdx.x; t < 2048; t += gridDim.x) {
    const int grp = t / 512, rem = t % 512; const int nq = rem / 32, mt = grp * 32 + rem % 32;
    const int m0 = mt * 256;
    f32x4 acc[4][8]; zero_acc<256, 256, 4, 2>(acc);
    mainloop1<256, 256, 4, 2, true>(lds, 512, Yg, [&](int r) { return (unsigned)(m0 + r) * 512u; }, Wg,
        [&](int c) { const int j = c >> 4; return (unsigned)(((j & 1) ? 2048 : 0) + nq * 128 + (j >> 1) * 16 + (c & 15)) * 512u; }, acc);
    const int lane = threadIdx.x & 63, wave = threadIdx.x >> 6; const int wm = wave % 4, wn = wave / 4; const int l15 = lane & 15, quad = lane >> 4;
#pragma unroll
    for (int i = 0; i < 4; ++i)
#pragma unroll
      for (int jj = 0; jj < 4; ++jj) {
        const int row = m0 + wm * 64 + i * 16 + l15, col = nq * 128 + (wn * 4 + jj) * 16 + quad * 4;
        const size_t idx = (size_t)row * 2048 + col;
        const uint2 g2 = *(const uint2*)(sga + idx);
        f32x4 o;
        o[0] = acc[i][2 * jj][0] * sigm(acc[i][2 * jj + 1][0]) * bflo(g2.x); o[1] = acc[i][2 * jj][1] * sigm(acc[i][2 * jj + 1][1]) * bfhi(g2.x);
        o[2] = acc[i][2 * jj][2] * sigm(acc[i][2 * jj + 1][2]) * bflo(g2.y); o[3] = acc[i][2 * jj][3] * sigm(acc[i][2 * jj + 1][3]) * bfhi(g2.y);
        *(uint2*)(ya + idx) = pack4(o);
      }
  }
}
__device__ __forceinline__ void phase7b(const KArgs& a, u16* lds) {
  const u16* Hn = (const u16*)(a.ws + OFF_R7); const u16* Wm = (const u16*)(a.ws + OFF_WMO);
  const u16* sgb = (const u16*)(a.ws + OFF_R5); const u16* ya = (const u16*)a.out; u16* mg = (u16*)(a.ws + OFF_R8);
  for (int t = blockIdx.x; t < 1024; t += gridDim.x) {
    const int grp = t / 256, rem = t % 256; const int nt = rem / 32, mt = grp * 32 + rem % 32;
    const int m0 = mt * 256, n0 = nt * 256;
    f32x4 acc[4][8]; zero_acc<256, 256, 4, 2>(acc);
    mainloop1<256, 256, 4, 2, true>(lds, 1536, Hn, [&](int r) { return (unsigned)(m0 + r) * 1536u; }, Wm, [&](int c) { return (unsigned)(n0 + c) * 1536u; }, acc);
    epilogue_t<256, 256, 4, 2>(acc, m0, n0, [&](int row, int col, f32x4 v) {
      const size_t idx = (size_t)row * 2048 + col;
      const uint2 y2 = *(const uint2*)(ya + idx), g2 = *(const uint2*)(sgb + idx);
      *(uint2*)(mg + idx) = pack4((f32x4){bflo(y2.x) + bflo(g2.x) * v[0], bfhi(y2.x) + bfhi(g2.x) * v[1], bflo(y2.y) + bflo(g2.y) * v[2], bfhi(y2.y) + bfhi(g2.y) * v[3]});
    });
  }
}

__device__ __forceinline__ void phase8(const KArgs& a, u16* lds) {
  const u16* mg = (const u16*)(a.ws + OFF_R8); const u16* W = (const u16*)(a.ws + OFF_WOUT); const float* x = a.in[0]; u16* h1b = (u16*)(a.ws + OFF_H1B);
  for (int t = blockIdx.x; t < 1024; t += gridDim.x) {
    const int grp = t / 256, rem = t % 256; const int nt = rem / 32, mt = grp * 32 + rem % 32;
    const int m0 = mt * 256, n0 = nt * 256;
    f32x4 acc[4][8]; zero_acc<256, 256, 4, 2>(acc);
    mainloop1<256, 256, 4, 2, true>(lds, 2048, mg, [&](int r) { return (unsigned)(m0 + r) * 2048u; }, W, [&](int c) { return (unsigned)(n0 + c) * 2048u; }, acc);
    epilogue_t<256, 256, 4, 2>(acc, m0, n0, [&](int row, int col, f32x4 v) {
      const size_t idx = (size_t)row * 2048 + col;
      const float4 xv = *(const float4*)(x + idx);
      *(uint2*)(h1b + idx) = pack4((f32x4){xv.x + v[0], xv.y + v[1], xv.z + v[2], xv.w + v[3]});
    });
  }
}

__device__ __forceinline__ void phase9(const KArgs& a) {
  {
    const int lane = threadIdx.x & 63; const int gw = blockIdx.x * 8 + (threadIdx.x >> 6); const int nw = gridDim.x * 8;
    const u16* src = (const u16*)(a.ws + OFF_H1B); const float* g = a.in[23]; u16* dst = (u16*)(a.ws + OFF_R1);
    unsigned char* t8 = a.ws + OFF_R7; float* tsc = (float*)(a.ws + OFF_R7 + 64 * MBy);
    for (int r = gw; r < T; r += nw) {
      const uint2* p = (const uint2*)(src + (size_t)r * D);
      float4 v[8]; float ss = 0.f;
#pragma unroll
      for (int i = 0; i < 8; ++i) { const uint2 w = p[lane + i * 64]; v[i] = make_float4(bflo(w.x), bfhi(w.x), bflo(w.y), bfhi(w.y)); ss += v[i].x * v[i].x + v[i].y * v[i].y + v[i].z * v[i].z + v[i].w * v[i].w; }
      ss = wave_sum(ss);
      const float rs = rsqrtf(ss * (1.f / D) + 1e-6f);
      float mx = 0.f;
#pragma unroll
      for (int i = 0; i < 8; ++i) {
        const float4 gg = ((const float4*)g)[lane + i * 64];
        v[i].x *= rs * gg.x; v[i].y *= rs * gg.y; v[i].z *= rs * gg.z; v[i].w *= rs * gg.w;
        mx = fmaxf(mx, fmaxf(fmaxf(fabsf(v[i].x), fabsf(v[i].y)), fmaxf(fabsf(v[i].z), fabsf(v[i].w))));
        uint2 o; o.x = pack2(v[i].x, v[i].y); o.y = pack2(v[i].z, v[i].w);
        ((uint2*)(dst + (size_t)r * D))[lane + i * 64] = o;
      }
      mx = wave_maxf(mx);
      const float sc = mx > 0.f ? 224.f / mx : 1.f;
      if (lane == 0) tsc[r] = 1.f / sc;
#pragma unroll
      for (int i = 0; i < 8; ++i) ((unsigned*)(t8 + (size_t)r * D))[lane + i * 64] = pk4_fp8(v[i], sc);
    }
  }
  convert_fp8_rows(a.in[27], a.ws + OFF_R2, (float*)(a.ws + OFF_ESC), 16384);
  convert_fp8_rows(a.in[28], a.ws + OFF_R2 + 32 * MBy, (float*)(a.ws + OFF_ESC) + 16384, 16384);
}

__device__ __forceinline__ void phase10(const KArgs& a, u16* lds) {
  const u16* hn2 = (const u16*)(a.ws + OFF_R1); const u16* W = (const u16*)(a.ws + OFF_WQRY); u16* qr = (u16*)(a.ws + OFF_R8);
  for (int t = blockIdx.x; t < 1024; t += gridDim.x) {
    const int grp = t / 256, rem = t % 256; const int nt = rem / 32, mt = grp * 32 + rem % 32;
    const int m0 = mt * 256, n0 = nt * 256;
    f32x4 acc[4][8]; zero_acc<256, 256, 4, 2>(acc);
    mainloop1<256, 256, 4, 2, true>(lds, 2048, hn2, [&](int r) { return (unsigned)(m0 + r) * 2048u; }, W, [&](int c) { return (unsigned)(n0 + c) * 2048u; }, acc);
    epilogue_t<256, 256, 4, 2>(acc, m0, n0, [&](int row, int col, f32x4 v) { *(uint2*)(qr + (size_t)row * 2048 + col) = pack4(v); });
  }
}

__device__ __forceinline__ void phase11(const KArgs& a, u16* lds) {
  const u16* qr = (const u16*)(a.ws + OFF_R8); float* sc = (float*)(a.ws + OFF_R4);
  for (int t = blockIdx.x; t < 2048; t += gridDim.x) {
    const int hw = t / 128, mt = t % 128; const int h = hw >> 1, which = hw & 1;
    const int m0 = mt * 256;
    const u16* Kb = (const u16*)(a.ws + (which ? OFF_KEY2 : OFF_KEY1)) + (size_t)h * 16384;
    f32x4 acc[4][4]; zero_acc<256, 128, 4, 2>(acc);
    mainloop<256, 128, 4, 2, true>(lds, 128, qr + h * 256 + which * 128, [&](int r) { return (unsigned)(m0 + r) * 2048u; }, Kb, [&](int c) { return (unsigned)c * 128u; }, acc);
    epilogue_t<256, 128, 4, 2>(acc, m0, 0, [&](int row, int col, f32x4 v) { *(f32x4*)(sc + (size_t)row * 2048 + h * 256 + which * 128 + col) = v; });
  }
}

constexpr size_t OFF_EIDX = 932 * MBy, OFF_GATE = 940 * MBy, OFF_ACT = 956 * MBy, OFF_T8 = OFF_R7, OFF_TSC = OFF_R7 + 64 * MBy;

__device__ __forceinline__ unsigned wave_maxu_dpp(unsigned v) {
  unsigned t;
  t = (unsigned)__builtin_amdgcn_update_dpp(0, (int)v, 0x121, 0xf, 0xf, false); v = t > v ? t : v;
  t = (unsigned)__builtin_amdgcn_update_dpp(0, (int)v, 0x122, 0xf, 0xf, false); v = t > v ? t : v;
  t = (unsigned)__builtin_amdgcn_update_dpp(0, (int)v, 0x124, 0xf, 0xf, false); v = t > v ? t : v;
  t = (unsigned)__builtin_amdgcn_update_dpp(0, (int)v, 0x128, 0xf, 0xf, false); v = t > v ? t : v;
  const unsigned a0 = (unsigned)__builtin_amdgcn_readlane((int)v, 0), a1 = (unsigned)__builtin_amdgcn_readlane((int)v, 16);
  const unsigned a2 = (unsigned)__builtin_amdgcn_readlane((int)v, 32), a3 = (unsigned)__builtin_amdgcn_readlane((int)v, 48);
  const unsigned m0 = a0 > a1 ? a0 : a1, m1 = a2 > a3 ? a2 : a3;
  return m0 > m1 ? m0 : m1;
}
__device__ __forceinline__ float rdlane_f(float v, int l) { return __int_as_float(__builtin_amdgcn_readlane(__float_as_int(v), l)); }

__device__ __forceinline__ int mbcnt64(unsigned long long m) { return __builtin_amdgcn_mbcnt_hi((unsigned)(m >> 32), __builtin_amdgcn_mbcnt_lo((unsigned)m, 0)); }
__device__ __forceinline__ float wave_maxf_dpp(float v) {
  float t;
  t = __int_as_float(__builtin_amdgcn_update_dpp(0, __float_as_int(v), 0x121, 0xf, 0xf, false)); v = fmaxf(v, t);
  t = __int_as_float(__builtin_amdgcn_update_dpp(0, __float_as_int(v), 0x122, 0xf, 0xf, false)); v = fmaxf(v, t);
  t = __int_as_float(__builtin_amdgcn_update_dpp(0, __float_as_int(v), 0x124, 0xf, 0xf, false)); v = fmaxf(v, t);
  t = __int_as_float(__builtin_amdgcn_update_dpp(0, __float_as_int(v), 0x128, 0xf, 0xf, false)); v = fmaxf(v, t);
  return fmaxf(fmaxf(rdlane_f(v, 0), rdlane_f(v, 16)), fmaxf(rdlane_f(v, 32), rdlane_f(v, 48)));
}

__device__ __forceinline__ float keyval(unsigned k, unsigned lowmask) {
  k &= ~lowmask;
  return __uint_as_float((k & 0x80000000u) ? (k & 0x7fffffffu) : ~k);
}
__device__ __forceinline__ void ins16(unsigned (&arr)[16], unsigned x) {
#pragma unroll
  for (int j = 0; j < 16; ++j) { const unsigned hi = arr[j] > x ? arr[j] : x; x = arr[j] > x ? x : arr[j]; arr[j] = hi; }
}
__device__ __forceinline__ unsigned sel16(const unsigned (&arr)[16], int idx) {
  unsigned r = arr[0];
#pragma unroll
  for (int j = 1; j < 16; ++j) r = (idx == j) ? arr[j] : r;
  return r;
}

__device__ __forceinline__ void phase12(const KArgs& a, unsigned char* ldsb) {
  const int lane = threadIdx.x & 63, wave = threadIdx.x >> 6; const int gw = blockIdx.x * 8 + wave; const int nw = gridDim.x * 8;
  const float* sc = (const float*)(a.ws + OFF_R4);
  u16* eidx = (u16*)(a.ws + OFF_EIDX); float* gates = (float*)(a.ws + OFF_GATE);
  unsigned* buf = (unsigned*)ldsb + wave * (64 * 33);
  const int lr = lane >> 3, lc = lane & 7;
  for (int task = gw; task < T * 8 / 64; task += nw) {
    const size_t item0 = (size_t)task * 64;
    unsigned a1[16], a2[16];
#pragma unroll
    for (int j = 0; j < 16; ++j) { a1[j] = 0u; a2[j] = 0u; }
    auto build = [&](unsigned (&arr)[16], const int w) {
#pragma unroll 1
      for (int ch = 0; ch < 4; ++ch) {
        f32x4 v[8];
#pragma unroll
        for (int p = 0; p < 8; ++p) v[p] = *(const f32x4*)(sc + (item0 + lr + 8 * p) * 256 + w * 128 + ch * 32 + lc * 4);
#pragma unroll
        for (int p = 0; p < 8; ++p) {
          unsigned* d = buf + (lr + 8 * p) * 33 + lc * 4;
          d[0] = __float_as_uint(v[p][0]); d[1] = __float_as_uint(v[p][1]); d[2] = __float_as_uint(v[p][2]); d[3] = __float_as_uint(v[p][3]);
        }
#pragma unroll
        for (int e = 0; e < 32; ++e) {
          const float x = __uint_as_float(buf[lane * 33 + e]);
          ins16(arr, (ordkey(x) & ~127u) | (unsigned)(127 - (ch * 32 + e)));
        }
      }
    };
    build(a1, 0);
    build(a2, 1);
    unsigned* kb = buf + lane * 33;
#pragma unroll
    for (int j = 0; j < 16; ++j) { kb[j] = a1[j]; kb[16 + j] = a2[j]; }
    float v2[16];
#pragma unroll
    for (int j = 0; j < 16; ++j) v2[j] = keyval(a2[j], 127u);
    unsigned c[16];
#pragma unroll
    for (int j = 0; j < 16; ++j) c[j] = 0u;
#pragma unroll 1
    for (int ai = 0; ai < 16; ++ai) {
      const float va = keyval(kb[ai], 127u);
#pragma unroll
      for (int bi = 0; bi < 16; ++bi) ins16(c, (ordkey(va + v2[bi]) & ~255u) | (unsigned)(255 - (ai * 16 + bi)));
    }
    const float mx = keyval(c[0], 255u);
    float ev[16]; float es = 0.f; unsigned ex[16];
#pragma unroll
    for (int j = 0; j < 16; ++j) {
      ev[j] = __expf(keyval(c[j], 255u) - mx); es += ev[j];
      const int ci = 255 - (int)(c[j] & 255u);
      const unsigned k1 = kb[ci >> 4], k2 = kb[16 + (ci & 15)];
      ex[j] = (127u - (k1 & 127u)) * 128u + (127u - (k2 & 127u));
    }
    const float inv = 1.f / es;
    const size_t ob = (item0 + lane) * 16;
    uint4 o0, o1;
    o0.x = ex[0] | (ex[1] << 16); o0.y = ex[2] | (ex[3] << 16); o0.z = ex[4] | (ex[5] << 16); o0.w = ex[6] | (ex[7] << 16);
    o1.x = ex[8] | (ex[9] << 16); o1.y = ex[10] | (ex[11] << 16); o1.z = ex[12] | (ex[13] << 16); o1.w = ex[14] | (ex[15] << 16);
    *(uint4*)(eidx + ob) = o0; *(uint4*)(eidx + ob + 8) = o1;
#pragma unroll
    for (int q = 0; q < 4; ++q) *(float4*)(gates + ob + q * 4) = make_float4(ev[q * 4] * inv, ev[q * 4 + 1] * inv, ev[q * 4 + 2] * inv, ev[q * 4 + 3] * inv);
  }
}

__device__ __forceinline__ void flush_rows(const float* stg, u16* dstbase, size_t rowlen, int tok0, int tstride, int nslot, int coloff) {
  const int lane = threadIdx.x & 63;
#pragma unroll
  for (int k = 0; k < 8; ++k) {
    const int idx = k * 64 + lane; const int slot = idx >> 5, off = idx & 31;
    if (slot < nslot) {
      const float4 v = ((const float4*)stg)[idx];
      uint2 o; o.x = pack2(v.x, v.y); o.y = pack2(v.z, v.w);
      *(uint2*)(dstbase + (size_t)(tok0 + slot * tstride) * rowlen + coloff + off * 4) = o;
    }
  }
}

__device__ __forceinline__ void phase13(const KArgs& a, unsigned char* ldsb, const int emask = 0xffff) {
  const int lane = threadIdx.x & 63, wave = threadIdx.x >> 6, l15 = lane & 15, quad = lane >> 4;
  const int lr = lane >> 3, lc = lane & 7;
  const u16* eidx = (const u16*)(a.ws + OFF_EIDX); const unsigned char* Eu8 = a.ws + OFF_R2; const unsigned char* t8 = a.ws + OFF_T8;
  u16* partial = (u16*)(a.ws + OFF_R4);
  float* stg = (float*)ldsb + wave * 2048;
  unsigned char* tb = ldsb + 65536 + wave * 9216;
  const XInfo xinf = xinfo(a); const int lb = xinf.lb, nlb = xinf.nlb; const int tstride = nlb * 8;
  for (int sl = xinf.xi; sl < 16; sl += xinf.np) {
    const unsigned char* ubase = Eu8 + (size_t)sl * (16384 * 128) + lc * 16;
    const size_t coff = (size_t)sl * 128 + quad * 32;
    int tok = lb * 8 + wave;
    int e[16];
    {
      const int t0 = tok < T ? tok : T - 1;
#pragma unroll
      for (int i = 0; i < 16; ++i) e[i] = eidx[(size_t)t0 * 128 + i * 8 + lr] & emask;
    }
    int j = 0, tok0 = tok;
    for (; tok < T; tok += tstride) {
      uint4 rr[16];
#pragma unroll
      for (int i = 0; i < 16; ++i) rr[i] = *(const uint4*)(ubase + (size_t)e[i] * 128);
      const uint4* bp = (const uint4*)(t8 + (size_t)tok * 2048 + coff);
      const uint4 b0 = bp[0], b1 = bp[1];
      {
        const int ntok = tok + tstride < T ? tok + tstride : T - 1;
#pragma unroll
        for (int i = 0; i < 16; ++i) e[i] = eidx[(size_t)ntok * 128 + i * 8 + lr] & emask;
      }
      const long bk[4] = {(long)(((unsigned long)b0.y << 32) | b0.x), (long)(((unsigned long)b0.w << 32) | b0.z),
                          (long)(((unsigned long)b1.y << 32) | b1.x), (long)(((unsigned long)b1.w << 32) | b1.z)};
#pragma unroll
      for (int half = 0; half < 2; ++half) {
#pragma unroll
        for (int i = 0; i < 8; ++i) *(uint4*)(tb + (i * 8 + lr) * 144 + lc * 16) = rr[half * 8 + i];
#pragma unroll
        for (int g4 = 0; g4 < 4; ++g4) {
          const uint4* ap = (const uint4*)(tb + (g4 * 16 + l15) * 144 + quad * 32);
          const uint4 a0 = ap[0], a1 = ap[1];
          const long ak[4] = {(long)(((unsigned long)a0.y << 32) | a0.x), (long)(((unsigned long)a0.w << 32) | a0.z),
                              (long)(((unsigned long)a1.y << 32) | a1.x), (long)(((unsigned long)a1.w << 32) | a1.z)};
          f32x4 acc = (f32x4){0.f, 0.f, 0.f, 0.f};
#pragma unroll
          for (int ks = 0; ks < 4; ++ks) acc = __builtin_amdgcn_mfma_f32_16x16x32_fp8_fp8(ak[ks], bk[ks], acc, 0, 0, 0);
          if (l15 == 0) *(float4*)(stg + j * 128 + (half * 4 + g4) * 16 + quad * 4) = make_float4(acc[0], acc[1], acc[2], acc[3]);
        }
      }
      if (++j == 16) { flush_rows(stg, partial + (size_t)sl * T * 128, 128, tok0, tstride, 16, 0); j = 0; tok0 = tok + tstride; }
    }
    if (j) flush_rows(stg, partial + (size_t)sl * T * 128, 128, tok0, tstride, j, 0);
  }
}

__device__ __forceinline__ void phase14(const KArgs& a) {
  const u16* partial = (const u16*)(a.ws + OFF_R4); const u16* eidx = (const u16*)(a.ws + OFF_EIDX);
  const float* gates = (const float*)(a.ws + OFF_GATE); float* act = (float*)(a.ws + OFF_ACT);
  const float* esc = (const float*)(a.ws + OFF_ESC); const float* tsc = (const float*)(a.ws + OFF_TSC);
  for (size_t i = (size_t)blockIdx.x * NT + threadIdx.x; i < (size_t)T * 128; i += (size_t)gridDim.x * NT) {
    float s = 0.f;
#pragma unroll
    for (int sl = 0; sl < 16; ++sl) s += bf2f(partial[(size_t)sl * T * 128 + i]);
    const int e = eidx[i]; const int tok = (int)(i >> 7);
    const float d = s * esc[e] * tsc[tok];
    act[i] = gelu_t(d) * gates[i] * esc[16384 + e];
  }
}

__device__ __forceinline__ void phase15(const KArgs& a, unsigned char* ldsb) {
  const int lane = threadIdx.x & 63, wave = threadIdx.x >> 6, c16 = lane & 15, esub = lane >> 4;
  const u16* eidx = (const u16*)(a.ws + OFF_EIDX); const float* act = (const float*)(a.ws + OFF_ACT);
  const unsigned char* Ev8 = a.ws + OFF_R2 + 32 * MBy; u16* po = (u16*)(a.ws + OFF_R5);
  uint2* ent = (uint2*)ldsb + wave * 128;
  float* stg = (float*)(ldsb + 8192) + wave * 2048;
  const XInfo xinf = xinfo(a); const int lb = xinf.lb, nlb = xinf.nlb; const int tstride = nlb * 8;
  for (int sl = xinf.xi; sl < 16; sl += xinf.np) {
    const unsigned char* vbase = Ev8 + (size_t)sl * (16384 * 128) + c16 * 8;
    int j = 0, tok0 = lb * 8 + wave;
    for (int tok = lb * 8 + wave; tok < T; tok += tstride) {
      {
        const unsigned ee = *(const unsigned*)(eidx + (size_t)tok * 128 + lane * 2);
        const float2 aa = *(const float2*)(act + (size_t)tok * 128 + lane * 2);
        uint4 w; w.x = (ee & 0xffffu) * 128u; w.y = __float_as_uint(aa.x); w.z = (ee >> 16) * 128u; w.w = __float_as_uint(aa.y);
        *(uint4*)(ent + lane * 2) = w;
      }
      asm volatile("" ::: "memory");
      uint2 vv[32]; float av[32];
#pragma unroll
      for (int i = 0; i < 32; ++i) {
        const uint2 en = ent[i * 4 + esub];
        vv[i] = *(const uint2*)(vbase + en.x); av[i] = __uint_as_float(en.y);
      }
      f32x2 o2[4];
#pragma unroll
      for (int k = 0; k < 4; ++k) o2[k] = (f32x2){0.f, 0.f};
#pragma unroll
      for (int i = 0; i < 32; ++i) {
        const f32x2 p0 = __builtin_amdgcn_cvt_pk_f32_fp8((int)vv[i].x, false), p1 = __builtin_amdgcn_cvt_pk_f32_fp8((int)vv[i].x, true);
        const f32x2 p2 = __builtin_amdgcn_cvt_pk_f32_fp8((int)vv[i].y, false), p3 = __builtin_amdgcn_cvt_pk_f32_fp8((int)vv[i].y, true);
        const f32x2 a2 = (f32x2){av[i], av[i]};
        o2[0] = __builtin_elementwise_fma(a2, p0, o2[0]); o2[1] = __builtin_elementwise_fma(a2, p1, o2[1]);
        o2[2] = __builtin_elementwise_fma(a2, p2, o2[2]); o2[3] = __builtin_elementwise_fma(a2, p3, o2[3]);
      }
      float o[8] = {o2[0][0], o2[0][1], o2[1][0], o2[1][1], o2[2][0], o2[2][1], o2[3][0], o2[3][1]};
#pragma unroll
      for (int k = 0; k < 8; ++k) { o[k] += __shfl_xor(o[k], 16); o[k] += __shfl_xor(o[k], 32); }
      if (esub == 0) {
        float4* dst = (float4*)(stg + j * 128 + c16 * 8);
        dst[0] = make_float4(o[0], o[1], o[2], o[3]); dst[1] = make_float4(o[4], o[5], o[6], o[7]);
      }
      asm volatile("" ::: "memory");
      if (++j == 16) { flush_rows(stg, po, 2048, tok0, tstride, 16, sl * 128); j = 0; tok0 = tok + tstride; }
    }
    if (j) flush_rows(stg, po, 2048, tok0, tstride, j, sl * 128);
  }
}

__device__ __forceinline__ void phase16(const KArgs& a) {
  const int lane = threadIdx.x & 63; const int gw = blockIdx.x * 8 + (threadIdx.x >> 6); const int nw = gridDim.x * 8;
  const u16* po = (const u16*)(a.ws + OFF_R5); const float* g = a.in[29]; float* out = a.out;
  for (int r = gw; r < T; r += nw) {
    const uint2* p = (const uint2*)((const u16*)(a.ws + OFF_H1B) + (size_t)r * D); const uint2* q = (const uint2*)(po + (size_t)r * D);
    float4 v[8]; float ss = 0.f;
#pragma unroll
    for (int i = 0; i < 8; ++i) {
      const uint2 x = p[lane + i * 64]; const uint2 y = q[lane + i * 64];
      v[i] = make_float4(bflo(x.x) + bflo(y.x), bfhi(x.x) + bfhi(y.x), bflo(x.y) + bflo(y.y), bfhi(x.y) + bfhi(y.y));
      ss += v[i].x * v[i].x + v[i].y * v[i].y + v[i].z * v[i].z + v[i].w * v[i].w;
    }
    ss = wave_sum(ss);
    const float rs = rsqrtf(ss * (1.f / D) + 1e-6f);
#pragma unroll
    for (int i = 0; i < 8; ++i) {
      const float4 gg = ((const float4*)g)[lane + i * 64];
      const f32x4 o4 = (f32x4){v[i].x * rs * gg.x, v[i].y * rs * gg.y, v[i].z * rs * gg.z, v[i].w * rs * gg.w};
      __builtin_nontemporal_store(o4, (f32x4*)(out + (size_t)r * D) + lane + i * 64);
    }
  }
}

__global__ void __launch_bounds__(NT) mega(KArgs a) {
  extern __shared__ __attribute__((aligned(16))) unsigned char ldsb[];
  u16* lds = (u16*)ldsb;
  cg::grid_group grid = cg::this_grid();
  const int lo = a.ph_lo, hi = a.ph_hi;
  volatile LAS unsigned* bst = (volatile LAS unsigned*)(LAS unsigned char*)(ldsb + LDS_BYTES - 16);
  if (threadIdx.x < 2) bst[threadIdx.x] = 0u;
  __syncthreads();
  XcdBarrier xbar; xbar.bar = (unsigned*)(a.ws + OFF_BAR); xbar.x = 0; xbar.st = bst;
#define GSYNC(k) do { if ((k) == 0) { grid.sync(); xbar = xcd_barrier_post((unsigned*)(a.ws + OFF_BAR), bst); } else xcd_barrier(xbar); } while (0)
#define PH(k, call) if (lo <= (k) && (k) < hi) { call; if ((k) + 1 < hi) GSYNC(k); }
  PH(0, phase0(a, ldsb))
  if (lo <= 1 && 1 < hi) census(a);
  PH(1, phase1(a, lds))
  PH(2, phase2(a, lds))
  PH(3, phase3(a, lds))
  PH(4, phase4(a, lds))
  PH(5, phase5(a, lds))
  PH(6, phase6(a))
  PH(7, phase7a(a, lds))
  PH(8, phase7b(a, lds))
  PH(9, phase8(a, lds))
  PH(10, phase9(a))
  PH(11, phase10(a, lds))
  PH(12, phase11(a, lds))
  PH(13, phase12(a, ldsb))
  PH(14, phase13(a, ldsb))
  PH(15, phase14(a))
  PH(16, phase15(a, ldsb))
  PH(17, phase16(a))
#undef PH
}

extern "C" void kernel_launch(void* const* d_in, const int* in_sizes, int n_in, void* d_out, int out_size, void* d_ws, size_t ws_size,
                              hipStream_t stream) {
  static int grid_blocks = 0;
  if (!grid_blocks) {
    if (ws_size < WS_END) { fprintf(stderr, "kernel_launch: workspace too small: %zu < %zu\n", ws_size, (size_t)WS_END); grid_blocks = -1; return; }
    int dev = 0, cus = 0, per_cu = 0;
    hipGetDevice(&dev);
    hipDeviceGetAttribute(&cus, hipDeviceAttributeMultiprocessorCount, dev);
    if (hipFuncSetAttribute((const void*)mega, hipFuncAttributeMaxDynamicSharedMemorySize, LDS_BYTES) != hipSuccess)
      fprintf(stderr, "kernel_launch: hipFuncSetAttribute failed\n");
    hipOccupancyMaxActiveBlocksPerMultiprocessor(&per_cu, (const void*)mega, NT, LDS_BYTES);
    if (per_cu < 1) { fprintf(stderr, "kernel_launch: occupancy query says %d blocks per CU\n", per_cu); per_cu = 1; }
    if (per_cu > 1) per_cu = 1;
    grid_blocks = cus * per_cu;
  }
  if (grid_blocks < 0) return;
  KArgs a{};
  for (int i = 0; i < 30; ++i) a.in[i] = (const float*)d_in[i];
  a.out = (float*)d_out; a.ws = (unsigned char*)d_ws;
#if MULTI
  for (int ph = 0; ph < NPH; ++ph) {
    a.ph_lo = ph; a.ph_hi = ph + 1;
    hipLaunchKernelGGL(mega, dim3(grid_blocks), dim3(NT), LDS_BYTES, stream, a);
  }
#else
  a.ph_lo = 0; a.ph_hi = NPH;
  void* args[] = {&a};
  hipError_t e = hipLaunchCooperativeKernel((const void*)mega, dim3(grid_blocks), dim3(NT), args, LDS_BYTES, stream);
  if (e != hipSuccess) fprintf(stderr, "cooperative launch failed: %s (grid %d)\n", hipGetErrorString(e), grid_blocks);
#endif
}
```

```cpp
#include <hip/hip_runtime.h>
#include <hip/hip_cooperative_groups.h>
#include <cstdio>
namespace cg = cooperative_groups;

#ifndef MULTI
#define MULTI 0
#endif
#ifndef PROBE13
#define PROBE13 0
#endif
#ifndef REPMASK
#define REPMASK 0
#endif

typedef unsigned short u16;
typedef __attribute__((ext_vector_type(8))) short bf16x8;
typedef __attribute__((ext_vector_type(4))) float f32x4;
typedef __attribute__((ext_vector_type(4))) unsigned u32x4;

constexpr int T = 32768, D = 2048;
constexpr int NT = 512, BK = 64, LROW = 72;
constexpr int GEMM_LDS = 2 * (256 + 128) * LROW * 2;
constexpr int LDS_BYTES = 151552;
constexpr int NPH = 18;

constexpr size_t MBy = 1u << 20;
constexpr size_t OFF_WIN = 0, OFF_WGLU = 31 * MBy, OFF_WQ = 35 * MBy, OFF_WK = 37 * MBy, OFF_WV = 39 * MBy,
                 OFF_WMO = 41 * MBy, OFF_WOUT = 47 * MBy, OFF_WQRY = 55 * MBy, OFF_KEY1 = 63 * MBy,
                 OFF_KEY2 = 63 * MBy + 512 * 1024, OFF_KMAT = 64 * MBy, OFF_EMAT = 65 * MBy, OFF_MMAT = 73 * MBy,
                 OFF_AL = 81 * MBy, OFF_GIF = 82 * MBy, OFF_GATES = 83 * MBy, OFF_V5 = 87 * MBy, OFF_X5 = 95 * MBy,
                 OFF_R1 = 100 * MBy, OFF_R2 = 228 * MBy, OFF_R3 = 324 * MBy, OFF_R6 = 420 * MBy, OFF_R7 = 452 * MBy,
                 OFF_R4 = 548 * MBy, OFF_R5 = 676 * MBy, OFF_R8 = 804 * MBy, OFF_R9 = 900 * MBy, OFF_R10 = 996 * MBy,
                 WS_END = 1012 * MBy;
constexpr size_t OFF_ESC = 81 * MBy + 128 * 1024;
constexpr size_t OFF_H1B = OFF_R2 + 64 * MBy;
constexpr size_t OFF_CTL = 81 * MBy + 512 * 1024;

struct KArgs { const float* in[30]; float* out; unsigned char* ws; int ph_lo, ph_hi; };

__device__ __forceinline__ u16 f2bf(float f) { unsigned u = __float_as_uint(f); u += 0x7fffu + ((u >> 16) & 1u); return (u16)(u >> 16); }
__device__ __forceinline__ float bf2f(u16 h) { return __uint_as_float(((unsigned)h) << 16); }
__device__ __forceinline__ float bflo(unsigned u) { return __uint_as_float(u << 16); }
__device__ __forceinline__ float bfhi(unsigned u) { return __uint_as_float(u & 0xffff0000u); }
__device__ __forceinline__ unsigned pack2(float a, float b) { return (unsigned)f2bf(a) | ((unsigned)f2bf(b) << 16); }
__device__ __forceinline__ float sigm(float x) { return 1.f / (1.f + __expf(-x)); }
__device__ __forceinline__ float gelu_t(float x) { return x * sigm(1.5957691216f * (x + 0.044715f * x * x * x)); }
__device__ __forceinline__ float wave_sum(float v) {
#pragma unroll
  for (int o = 32; o; o >>= 1) v += __shfl_xor(v, o);
  return v;
}
__device__ __forceinline__ unsigned wave_maxu(unsigned v) {
#pragma unroll
  for (int o = 32; o; o >>= 1) { unsigned t = (unsigned)__shfl_xor((int)v, o); v = t > v ? t : v; }
  return v;
}
__device__ __forceinline__ unsigned ordkey(float f) { unsigned u = __float_as_uint(f); return (u & 0x80000000u) ? ~u : (u | 0x80000000u); }


typedef __attribute__((ext_vector_type(2))) float f32x2;
__device__ __forceinline__ float wave_maxf(float v) {
#pragma unroll
  for (int o = 32; o; o >>= 1) v = fmaxf(v, __shfl_xor(v, o));
  return v;
}
__device__ __forceinline__ unsigned pk4_fp8(float4 f, float sc) {
  int w = 0;
  w = __builtin_amdgcn_cvt_pk_fp8_f32(f.x * sc, f.y * sc, w, false);
  w = __builtin_amdgcn_cvt_pk_fp8_f32(f.z * sc, f.w * sc, w, true);
  return (unsigned)w;
}
__device__ __forceinline__ void convert_fp8_rows(const float* __restrict__ src, unsigned char* __restrict__ dst, float* __restrict__ inv_scale, int nrows) {
  const int lane = threadIdx.x & 63; const int gw = blockIdx.x * 8 + (threadIdx.x >> 6); const int nw = gridDim.x * 8;
  for (int r = gw; r < nrows; r += nw) {
    const float4* p = (const float4*)(src + (size_t)r * 2048);
    float4 v[8]; float mx = 0.f;
#pragma unroll
    for (int i = 0; i < 2; ++i)
#pragma unroll
      for (int q = 0; q < 4; ++q) {
        v[i * 4 + q] = p[i * 256 + lane * 4 + q];
        mx = fmaxf(mx, fmaxf(fmaxf(fabsf(v[i * 4 + q].x), fabsf(v[i * 4 + q].y)), fmaxf(fabsf(v[i * 4 + q].z), fabsf(v[i * 4 + q].w))));
      }
    mx = wave_maxf(mx);
    const float sc = mx > 0.f ? 224.f / mx : 1.f;
    if (lane == 0) inv_scale[r] = 1.f / sc;
#pragma unroll
    for (int i = 0; i < 2; ++i) {
      uint4 o; o.x = pk4_fp8(v[i * 4 + 0], sc); o.y = pk4_fp8(v[i * 4 + 1], sc); o.z = pk4_fp8(v[i * 4 + 2], sc); o.w = pk4_fp8(v[i * 4 + 3], sc);
      *(uint4*)(dst + (size_t)(i * 8 + (lane >> 3)) * (16384 * 128) + (size_t)r * 128 + (lane & 7) * 16) = o;
    }
  }
}


#define XB_TMO      128
#define XB_XCNT(j)  (256  + 64 * (j))
#define XB_XSUB(j)  (1280 + 64 * (j))
#define XB_XGEN(j)  (2304 + 64 * (j))
#define XB_TOP      3328
#define XB_TOPGEN   3392
#define XCD_BAR_WORDS 3456
#define XB_SPIN_CAP (1u << 22)
#define LAS __attribute__((address_space(3)))
constexpr size_t OFF_BAR = 81 * MBy + 768 * 1024;
__device__ __forceinline__ unsigned xb_ld(unsigned* p)              { return __hip_atomic_load(p, __ATOMIC_RELAXED, __HIP_MEMORY_SCOPE_AGENT); }
__device__ __forceinline__ unsigned xb_add(unsigned* p, unsigned v) { return __hip_atomic_fetch_add(p, v, __ATOMIC_RELAXED, __HIP_MEMORY_SCOPE_AGENT); }
#define XB_SPIN(cond, bar) do { unsigned _sp = 0; while (cond) { __builtin_amdgcn_s_sleep(1); \
    if ((++_sp & 255u) == 0u) { if (xb_ld(&(bar)[XB_TMO])) break; if (_sp > XB_SPIN_CAP) { atomicAdd(&(bar)[XB_TMO], 1u); break; } } } } while (0)
struct XcdBarrier { unsigned* bar; unsigned x; volatile LAS unsigned* st; };
__device__ __forceinline__ XcdBarrier xcd_barrier_post(unsigned* bar, volatile LAS unsigned* st) {
  XcdBarrier b; b.bar = bar; b.x = (unsigned)__builtin_amdgcn_s_getreg((3 << 11) | 20) & 0xFu; b.st = st;
  if (threadIdx.x == 0) (void)xb_add(&bar[XB_XCNT(b.x)], 1u);
  return b;
}
__device__ __forceinline__ void xcd_barrier_complete(unsigned* bar, unsigned x, unsigned& nloc, unsigned& nx) {
  const unsigned G = gridDim.x * gridDim.y * gridDim.z;
  unsigned sum, cnt, mine, sp = 0u;
  for (;;) {
    sum = 0u; cnt = 0u; mine = 0u;
#pragma unroll
    for (unsigned j = 0; j < 16; ++j) { const unsigned c = xb_ld(&bar[XB_XCNT(j)]); sum += c; cnt += (c > 0u) ? 1u : 0u; mine = (j == x) ? c : mine; }
    if (sum == G) break;
    __builtin_amdgcn_s_sleep(1);
    if ((++sp & 255u) == 0u) { if (xb_ld(&bar[XB_TMO])) break; if (sp > XB_SPIN_CAP) { atomicAdd(&bar[XB_TMO], 1u); break; } }
  }
  nloc = mine > 0u ? mine : 1u; nx = cnt > 0u ? cnt : 1u;
}
__device__ __forceinline__ void xcd_barrier(const XcdBarrier& b) {
  asm volatile("s_waitcnt vmcnt(0)" ::: "memory");
  __syncthreads();
  if (threadIdx.x == 0) {
    unsigned* bar = b.bar;
    __builtin_amdgcn_s_waitcnt(0);
    unsigned nloc = b.st[0], nx = b.st[1];
    if (nloc == 0u) { xcd_barrier_complete(bar, b.x, nloc, nx); b.st[0] = nloc; b.st[1] = nx; }
    const unsigned old = xb_add(&bar[XB_XSUB(b.x)], 1u);
    const unsigned gen = old / nloc;
    if (old + 1u == (gen + 1u) * nloc) {
      __builtin_amdgcn_fence(__ATOMIC_RELEASE, "agent");
      asm volatile("s_waitcnt vmcnt(0)" ::: "memory");
      const unsigned og = xb_add(&bar[XB_TOP], 1u);
      const unsigned tg = og / nx;
      if (og + 1u == (tg + 1u) * nx) xb_add(&bar[XB_TOPGEN], 1u);
      else XB_SPIN(xb_ld(&bar[XB_TOPGEN]) == tg, bar);
      __builtin_amdgcn_fence(__ATOMIC_ACQUIRE, "agent");
      xb_add(&bar[XB_XGEN(b.x)], 1u);
      asm volatile("s_waitcnt vmcnt(0)" ::: "memory");
    } else {
      XB_SPIN(xb_ld(&bar[XB_XGEN(b.x)]) == gen, bar);
      __builtin_amdgcn_fence(__ATOMIC_ACQUIRE, "agent");
      asm volatile("s_waitcnt vmcnt(0)" ::: "memory");
    }
  }
  __syncthreads();
}

__device__ __forceinline__ unsigned xcc_id() { return (unsigned)__builtin_amdgcn_s_getreg((3 << 11) | 20) & 0xFu; }
__device__ __forceinline__ void census(const KArgs& a) {
  if (threadIdx.x == 0) {
    unsigned* ctl = (unsigned*)(a.ws + OFF_CTL);
    const unsigned x = xcc_id();
    const unsigned r = atomicAdd(&ctl[x], 1u);
    ctl[16 + blockIdx.x] = (x << 16) | r;
  }
}
struct XInfo { int xi, np, lb, nlb, vb; };
__device__ __forceinline__ XInfo xinfo(const KArgs& a) {
  const unsigned* ctl = (const unsigned*)(a.ws + OFF_CTL);
  const unsigned w = ctl[16 + blockIdx.x]; const int x = (int)(w >> 16), r = (int)(w & 0xffffu);
  XInfo o; o.xi = 0; o.np = 0; o.vb = r;
#pragma unroll
  for (int j = 0; j < 16; ++j) { const int c = (int)ctl[j]; if (c > 0) { o.np++; if (j < x) { o.xi++; o.vb += c; } } }
  o.lb = r; o.nlb = (int)ctl[x];
  return o;
}

template <int BM, int BN, int WM, int WN, class AF, class BF>
__device__ __forceinline__ void mainloop_gen(u16* lds, int K, AF af, BF bf, f32x4 (&acc)[BM / WM / 16][BN / WN / 16]) {
  constexpr int TM = BM / WM / 16, TN = BN / WN / 16;
  constexpr int ACH = BM * 8 / NT, BCH = BN * 8 / NT;
  static_assert(ACH >= 1 && BCH >= 1, "tile too small");
  const int tid = threadIdx.x, lane = tid & 63, wave = tid >> 6;
  const int wm = wave % WM, wn = wave / WM;
  const int l15 = lane & 15, quad = lane >> 4;
  uint4 ra[ACH], rb[BCH];
  const int nk = K / BK;
  auto gload = [&](int k0) {
#pragma unroll
    for (int i = 0; i < ACH; ++i) {
      int c = tid + i * NT; int r = c >> 3, kc = (c & 7) * 8;
      const u16* p = af(r, k0 + kc);
      ra[i] = p ? *(const uint4*)p : make_uint4(0, 0, 0, 0);
    }
#pragma unroll
    for (int i = 0; i < BCH; ++i) {
      int c = tid + i * NT; int r = c >> 3, kc = (c & 7) * 8;
      const u16* p = bf(r, k0 + kc);
      rb[i] = p ? *(const uint4*)p : make_uint4(0, 0, 0, 0);
    }
  };
  auto lstore = [&](int s) {
    u16* sa = lds + s * (BM + BN) * LROW; u16* sb = sa + BM * LROW;
#pragma unroll
    for (int i = 0; i < ACH; ++i) { int c = tid + i * NT; int r = c >> 3, kc = (c & 7) * 8; *(uint4*)(sa + r * LROW + kc) = ra[i]; }
#pragma unroll
    for (int i = 0; i < BCH; ++i) { int c = tid + i * NT; int r = c >> 3, kc = (c & 7) * 8; *(uint4*)(sb + r * LROW + kc) = rb[i]; }
  };
  gload(0); lstore(0); __syncthreads();
  for (int kt = 0; kt < nk; ++kt) {
    if (kt + 1 < nk) gload((kt + 1) * BK);
    const int s = kt & 1;
    const u16* sa = lds + s * (BM + BN) * LROW + (wm * (BM / WM) + l15) * LROW + quad * 8;
    const u16* sb = lds + s * (BM + BN) * LROW + BM * LROW + (wn * (BN / WN) + l15) * LROW + quad * 8;
#pragma unroll
    for (int kk = 0; kk < 2; ++kk) {
      bf16x8 fa[TM], fb[TN];
#pragma unroll
      for (int i = 0; i < TM; ++i) fa[i] = *(const bf16x8*)(sa + i * 16 * LROW + kk * 32);
#pragma unroll
      for (int j = 0; j < TN; ++j) fb[j] = *(const bf16x8*)(sb + j * 16 * LROW + kk * 32);
#pragma unroll
      for (int i = 0; i < TM; ++i)
#pragma unroll
        for (int j = 0; j < TN; ++j) acc[i][j] = __builtin_amdgcn_mfma_f32_16x16x32_bf16(fa[i], fb[j], acc[i][j], 0, 0, 0);
    }
    if (kt + 1 < nk) lstore((kt + 1) & 1);
    __syncthreads();
  }
}
template <int BM, int BN, int WM, int WN, bool SWAP = false, int AKM = 1, class AF, class BF>
__device__ __forceinline__ void mainloop(u16* lds, int K, const u16* __restrict__ abase, AF aoff, const u16* __restrict__ bbase, BF boff, f32x4 (&acc)[BM / WM / 16][BN / WN / 16]) {
  constexpr int TM = BM / WM / 16, TN = BN / WN / 16;
  constexpr int ACH = BM * 8 / NT, BCH = BN * 8 / NT;
  static_assert(ACH >= 1 && BCH >= 1, "tile too small");
  const int tid = threadIdx.x, lane = tid & 63, wave = tid >> 6;
  const int wm = wave % WM, wn = wave / WM;
  const int l15 = lane & 15, quad = lane >> 4;
  u32x4 ra0[ACH], rb0[BCH], ra1[ACH], rb1[BCH];
  unsigned oa[ACH], ob[BCH];
#pragma unroll
  for (int i = 0; i < ACH; ++i) { int c = tid + i * NT; oa[i] = aoff(c >> 3) + (c & 7) * 8 * AKM; }
#pragma unroll
  for (int i = 0; i < BCH; ++i) { int c = tid + i * NT; ob[i] = boff(c >> 3) + (c & 7) * 8; }
  const int nk = K / BK;
#define DEF_STAGE(SFX, RA, RB) \
  auto gload##SFX = [&](int k0) { \
    const u16* ab_ = abase + k0 * AKM; const u16* bb_ = bbase + k0; \
    _Pragma("unroll") for (int i = 0; i < ACH; ++i) RA[i] = *(const u32x4*)(ab_ + oa[i]); \
    _Pragma("unroll") for (int i = 0; i < BCH; ++i) RB[i] = *(const u32x4*)(bb_ + ob[i]); \
  }; \
  auto lstore##SFX = [&](int st) { \
    u16* sa_ = lds + st * (BM + BN) * LROW; u16* sb_ = sa_ + BM * LROW; \
    _Pragma("unroll") for (int i = 0; i < ACH; ++i) { int c = tid + i * NT; int r = c >> 3, kc = (c & 7) * 8; *(u32x4*)(sa_ + r * LROW + kc) = RA[i]; } \
    _Pragma("unroll") for (int i = 0; i < BCH; ++i) { int c = tid + i * NT; int r = c >> 3, kc = (c & 7) * 8; *(u32x4*)(sb_ + r * LROW + kc) = RB[i]; } \
  };
  DEF_STAGE(0, ra0, rb0)
  DEF_STAGE(1, ra1, rb1)
#undef DEF_STAGE
  auto compute = [&](int st) {
    const u16* sa = lds + st * (BM + BN) * LROW + (wm * (BM / WM) + l15) * LROW + quad * 8;
    const u16* sb = lds + st * (BM + BN) * LROW + BM * LROW + (wn * (BN / WN) + l15) * LROW + quad * 8;
#pragma unroll
    for (int kk = 0; kk < 2; ++kk) {
      bf16x8 fa[TM], fb[TN];
#pragma unroll
      for (int i = 0; i < TM; ++i) fa[i] = *(const bf16x8*)(sa + i * 16 * LROW + kk * 32);
#pragma unroll
      for (int j = 0; j < TN; ++j) fb[j] = *(const bf16x8*)(sb + j * 16 * LROW + kk * 32);
#pragma unroll
      for (int i = 0; i < TM; ++i)
#pragma unroll
        for (int j = 0; j < TN; ++j) acc[i][j] = SWAP ? __builtin_amdgcn_mfma_f32_16x16x32_bf16(fb[j], fa[i], acc[i][j], 0, 0, 0) : __builtin_amdgcn_mfma_f32_16x16x32_bf16(fa[i], fb[j], acc[i][j], 0, 0, 0);
    }
  };
  gload0(0);
  gload1(BK);
  lstore0(0);
  lstore1(1);
  __syncthreads();
#pragma unroll 1
  for (int kt = 0; kt < nk; kt += 2) {
    const bool more = kt + 2 < nk;
    if (more) { gload0((kt + 2) * BK); gload1((kt + 3) * BK); }
    compute(0);
    compute(1);
    __syncthreads();
    if (more) { lstore0(0); lstore1(1); }
    __syncthreads();
  }
}
template <int BM, int BN, int WM, int WN, bool SWAP = false, class AF, class BF>
__device__ __forceinline__ void mainloop1(u16* lds, int K, const u16* __restrict__ abase, AF aoff, const u16* __restrict__ bbase, BF boff, f32x4 (&acc)[BM / WM / 16][BN / WN / 16]) {
  constexpr int TM = BM / WM / 16, TN = BN / WN / 16;
  constexpr int ACH = BM * 8 / NT, BCH = BN * 8 / NT;
  static_assert(ACH >= 1 && BCH >= 1, "tile too small");
  const int tid = threadIdx.x, lane = tid & 63, wave = tid >> 6;
  const int wm = wave % WM, wn = wave / WM;
  const int l15 = lane & 15, quad = lane >> 4;
  u32x4 ra0[ACH], rb0[BCH];
  unsigned oa[ACH], ob[BCH];
#pragma unroll
  for (int i = 0; i < ACH; ++i) { int c = tid + i * NT; oa[i] = aoff(c >> 3) + (c & 7) * 8; }
#pragma unroll
  for (int i = 0; i < BCH; ++i) { int c = tid + i * NT; ob[i] = boff(c >> 3) + (c & 7) * 8; }
  const int nk = K / BK;
#define DEF_STAGE(SFX, RA, RB) \
  auto gload##SFX = [&](int k0) { \
    const u16* ab_ = abase + k0; const u16* bb_ = bbase + k0; \
    _Pragma("unroll") for (int i = 0; i < ACH; ++i) RA[i] = *(const u32x4*)(ab_ + oa[i]); \
    _Pragma("unroll") for (int i = 0; i < BCH; ++i) RB[i] = *(const u32x4*)(bb_ + ob[i]); \
  }; \
  auto lstore##SFX = [&](int st) { \
    u16* sa_ = lds + st * (BM + BN) * LROW; u16* sb_ = sa_ + BM * LROW; \
    _Pragma("unroll") for (int i = 0; i < ACH; ++i) { int c = tid + i * NT; int r = c >> 3, kc = (c & 7) * 8; *(u32x4*)(sa_ + r * LROW + kc) = RA[i]; } \
    _Pragma("unroll") for (int i = 0; i < BCH; ++i) { int c = tid + i * NT; int r = c >> 3, kc = (c & 7) * 8; *(u32x4*)(sb_ + r * LROW + kc) = RB[i]; } \
  };
  DEF_STAGE(0, ra0, rb0)
#undef DEF_STAGE
  auto compute = [&](int st) {
    const u16* sa = lds + st * (BM + BN) * LROW + (wm * (BM / WM) + l15) * LROW + quad * 8;
    const u16* sb = lds + st * (BM + BN) * LROW + BM * LROW + (wn * (BN / WN) + l15) * LROW + quad * 8;
#pragma unroll
    for (int kk = 0; kk < 2; ++kk) {
      bf16x8 fa[TM], fb[TN];
#pragma unroll
      for (int i = 0; i < TM; ++i) fa[i] = *(const bf16x8*)(sa + i * 16 * LROW + kk * 32);
#pragma unroll
      for (int j = 0; j < TN; ++j) fb[j] = *(const bf16x8*)(sb + j * 16 * LROW + kk * 32);
#pragma unroll
      for (int i = 0; i < TM; ++i)
#pragma unroll
        for (int j = 0; j < TN; ++j) acc[i][j] = SWAP ? __builtin_amdgcn_mfma_f32_16x16x32_bf16(fb[j], fa[i], acc[i][j], 0, 0, 0) : __builtin_amdgcn_mfma_f32_16x16x32_bf16(fa[i], fb[j], acc[i][j], 0, 0, 0);
    }
  };
  gload0(0);
  lstore0(0);
  __syncthreads();
#pragma unroll 1
  for (int kt = 0; kt < nk; ++kt) {
    const bool more = kt + 1 < nk;
    if (more) gload0((kt + 1) * BK);
    compute(kt & 1);
    if (more) lstore0((kt + 1) & 1);
    __syncthreads();
  }
}
template <int BM, int BN, int WM, int WN>
__device__ __forceinline__ void zero_acc(f32x4 (&acc)[BM / WM / 16][BN / WN / 16]) {
#pragma unroll
  for (int i = 0; i < BM / WM / 16; ++i)
#pragma unroll
    for (int j = 0; j < BN / WN / 16; ++j) acc[i][j] = (f32x4){0.f, 0.f, 0.f, 0.f};
}
template <int BM, int BN, int WM, int WN, class EF>
__device__ __forceinline__ void epilogue(f32x4 (&acc)[BM / WM / 16][BN / WN / 16], int m0, int n0, EF ef) {
  const int lane = threadIdx.x & 63, wave = threadIdx.x >> 6;
  const int wm = wave % WM, wn = wave / WM;
  const int l15 = lane & 15, quad = lane >> 4;
#pragma unroll
  for (int i = 0; i < BM / WM / 16; ++i)
#pragma unroll
    for (int j = 0; j < BN / WN / 16; ++j) ef(m0 + wm * (BM / WM) + i * 16 + quad * 4, n0 + wn * (BN / WN) + j * 16 + l15, acc[i][j]);
}

template <int BM, int BN, int WM, int WN, class EF>
__device__ __forceinline__ void epilogue_t(f32x4 (&acc)[BM / WM / 16][BN / WN / 16], int m0, int n0, EF ef) {
  const int lane = threadIdx.x & 63, wave = threadIdx.x >> 6;
  const int wm = wave % WM, wn = wave / WM;
  const int l15 = lane & 15, quad = lane >> 4;
#pragma unroll
  for (int i = 0; i < BM / WM / 16; ++i)
#pragma unroll
    for (int j = 0; j < BN / WN / 16; ++j) ef(m0 + wm * (BM / WM) + i * 16 + l15, n0 + wn * (BN / WN) + j * 16 + quad * 4, acc[i][j]);
}
__device__ __forceinline__ uint2 pack4(f32x4 v) { uint2 o; o.x = pack2(v[0], v[1]); o.y = pack2(v[2], v[3]); return o; }

template <class CM>
__device__ __forceinline__ void tconv(const float* __restrict__ src, int src_ld, int K, int N, u16* __restrict__ dst, float scale, CM colmap, float* tile) {
  const int tk = K / 64, tn = N / 64;
  for (int t = blockIdx.x; t < tk * tn; t += gridDim.x) {
    const int k0 = (t % tk) * 64, n0 = (t / tk) * 64;
#pragma unroll
    for (int i = 0; i < 8; ++i) {
      int idx = threadIdx.x + i * NT; int kk = idx >> 6, nn = idx & 63; int sc = colmap(n0 + nn);
      tile[kk * 65 + nn] = sc >= 0 ? src[(size_t)(k0 + kk) * src_ld + sc] * scale : 0.f;
    }
    __syncthreads();
#pragma unroll
    for (int i = 0; i < 8; ++i) {
      int idx = threadIdx.x + i * NT; int nn = idx >> 6, kk = idx & 63;
      dst[(size_t)(n0 + nn) * K + k0 + kk] = f2bf(tile[kk * 65 + nn]);
    }
    __syncthreads();
  }
}

__device__ __forceinline__ void rmsnorm_rows(const float* __restrict__ src, const float* __restrict__ g, u16* __restrict__ dst) {
  const int lane = threadIdx.x & 63; const int gw = blockIdx.x * 8 + (threadIdx.x >> 6); const int nw = gridDim.x * 8;
  for (int r = gw; r < T; r += nw) {
    const float4* p = (const float4*)(src + (size_t)r * D);
    float4 v[8]; float ss = 0.f;
#pragma unroll
    for (int i = 0; i < 8; ++i) { v[i] = p[lane + i * 64]; ss += v[i].x * v[i].x + v[i].y * v[i].y + v[i].z * v[i].z + v[i].w * v[i].w; }
    ss = wave_sum(ss);
    const float rs = rsqrtf(ss * (1.f / D) + 1e-6f);
#pragma unroll
    for (int i = 0; i < 8; ++i) {
      float4 gg = ((const float4*)g)[lane + i * 64];
      uint2 o; o.x = pack2(v[i].x * rs * gg.x, v[i].y * rs * gg.y); o.y = pack2(v[i].z * rs * gg.z, v[i].w * rs * gg.w);
      ((uint2*)(dst + (size_t)r * D))[lane + i * 64] = o;
    }
  }
}

__device__ __forceinline__ void convert_flat(const float* __restrict__ src, u16* __restrict__ dst, size_t n8) {
  for (size_t i = (size_t)blockIdx.x * NT + threadIdx.x; i < n8; i += (size_t)gridDim.x * NT) {
    float4 a = ((const float4*)src)[2 * i], b = ((const float4*)src)[2 * i + 1];
    uint4 o; o.x = pack2(a.x, a.y); o.y = pack2(a.z, a.w); o.z = pack2(b.x, b.y); o.w = pack2(b.z, b.w);
    ((uint4*)dst)[i] = o;
  }
}

__device__ void s5_build(const KArgs& a, float* sm) {
  float* aT = sm; float* aT1 = sm + 128; float* coef = sm + 256; float* Bb = sm + 384;
  const float* lam_re = a.in[3]; const float* lam_im = a.in[4]; const float* log_dt = a.in[5];
  const float* b_re = a.in[6]; const float* b_im = a.in[7]; const float* c_re = a.in[8]; const float* c_im = a.in[9];
  u16* Kmat = (u16*)(a.ws + OFF_KMAT); u16* Emat = (u16*)(a.ws + OFF_EMAT); u16* Mmat = (u16*)(a.ws + OFF_MMAT);
  float* aL = (float*)(a.ws + OFF_AL);
  const int tid = threadIdx.x;
  for (int item = blockIdx.x; item < 32 * 64; item += gridDim.x) {
    const int g = item >> 6, tau = item & 63;
    if (tid < 64) {
      const int p = tid;
      const float lr = lam_re[g * 64 + p], li = lam_im[g * 64 + p], dt = expf(log_dt[g]);
      const double wr = (double)lr * (double)dt, wi = (double)li * (double)dt;
      const double twopi = 6.283185307179586476925;
      auto cpow = [&](int n, float& re, float& im) {
        double th = wi * n; th -= twopi * rint(th / twopi);
        float mag = expf((float)(wr * n)); float s, c; s = sinf((float)th); c = cosf((float)th);
        re = mag * c; im = mag * s;
      };
      float ar, ai; cpow(1, ar, ai);
      float nr = ar - 1.f, ni = ai; float inv = 1.f / (lr * lr + li * li);
      coef[2 * p] = (nr * lr + ni * li) * inv; coef[2 * p + 1] = (ni * lr - nr * li) * inv;
      float r0, i0, r1, i1; cpow(tau, r0, i0); cpow(tau + 1, r1, i1);
      aT[2 * p] = r0; aT[2 * p + 1] = i0; aT1[2 * p] = r1; aT1[2 * p + 1] = i1;
      if (tau == 63) { aL[(g * 64 + p) * 2] = r1; aL[(g * 64 + p) * 2 + 1] = i1; }
    }
    __syncthreads();
    for (int idx = tid; idx < 1024; idx += NT) {
      const int p = idx >> 4;
      const float br = b_re[g * 1024 + idx], bi = b_im[g * 1024 + idx];
      const float cr = coef[2 * p], ci = coef[2 * p + 1];
      Bb[2 * idx] = cr * br - ci * bi; Bb[2 * idx + 1] = cr * bi + ci * br;
    }
    __syncthreads();
    if (tid < 256) {
      const int h = tid >> 4, h2 = tid & 15; float s = 0.f;
      for (int p = 0; p < 64; ++p) {
        const float cr = c_re[g * 1024 + h * 64 + p], ci = c_im[g * 1024 + h * 64 + p];
        const float car = cr * aT[2 * p] - ci * aT[2 * p + 1], cai = cr * aT[2 * p + 1] + ci * aT[2 * p];
        s += car * Bb[2 * (p * 16 + h2)] - cai * Bb[2 * (p * 16 + h2) + 1];
      }
      Kmat[((size_t)(g * 64 + tau) * 16 + h) * 16 + h2] = f2bf(s);
    }
    for (int idx = tid; idx < 1024; idx += NT) {
      {
        const int h = idx >> 6, p = idx & 63;
        const float cr = c_re[g * 1024 + idx], ci = c_im[g * 1024 + idx];
        const float car = cr * aT1[2 * p] - ci * aT1[2 * p + 1], cai = cr * aT1[2 * p + 1] + ci * aT1[2 * p];
        const size_t base = ((size_t)g * 1024 + tau * 16 + h) * 128;
        Emat[base + p] = f2bf(car); Emat[base + 64 + p] = f2bf(-cai);
      }
      {
        const int p = idx >> 4, h2 = idx & 15; const int s = 63 - tau;
        const float br = Bb[2 * idx], bi = Bb[2 * idx + 1];
        const float mr = aT[2 * p] * br - aT[2 * p + 1] * bi, mi = aT[2 * p] * bi + aT[2 * p + 1] * br;
        Mmat[((size_t)g * 128 + p) * 1024 + s * 16 + h2] = f2bf(mr);
        Mmat[((size_t)g * 128 + 64 + p) * 1024 + s * 16 + h2] = f2bf(mi);
      }
    }
    __syncthreads();
  }
}

__device__ __forceinline__ void phase0(const KArgs& a, unsigned char* ldsb) {
  float* tile = (float*)ldsb;
  if (blockIdx.x == 0) {
    if (threadIdx.x < 16) ((unsigned*)(a.ws + OFF_CTL))[threadIdx.x] = 0u;
    for (int i = threadIdx.x; i < XCD_BAR_WORDS; i += NT) ((unsigned*)(a.ws + OFF_BAR))[i] = 0u;
  }
  auto ident = [](int n) { return n; };
  tconv(a.in[2], 7688, 2048, 7808, (u16*)(a.ws + OFF_WIN), 1.f,
        [](int n) { return n < 3584 ? n : (n < 7680 ? n + 8 : (n < 7688 ? n - 7680 + 3584 : -1)); }, tile);
  tconv(a.in[11], 4096, 512, 4096, (u16*)(a.ws + OFF_WGLU), 1.f, ident, tile);
  for (int h = 0; h < 4; ++h) {
    tconv(a.in[14] + h * 147456, 384, 384, 384, (u16*)(a.ws + OFF_WQ) + h * 147456, 1.f, ident, tile);
    tconv(a.in[15] + h * 147456, 384, 384, 384, (u16*)(a.ws + OFF_WK) + h * 147456, 0.05103103630798288f, ident, tile);
    tconv(a.in[16] + h * 147456, 384, 384, 384, (u16*)(a.ws + OFF_WV) + h * 147456, 1.f, ident, tile);
  }
  tconv(a.in[21], 2048, 1536, 2048, (u16*)(a.ws + OFF_WMO), 1.f, ident, tile);
  tconv(a.in[22], 2048, 2048, 2048, (u16*)(a.ws + OFF_WOUT), 1.f, ident, tile);
  tconv(a.in[24], 2048, 2048, 2048, (u16*)(a.ws + OFF_WQRY), 1.f, ident, tile);
  convert_flat(a.in[25], (u16*)(a.ws + OFF_KEY1), 8 * 128 * 128 / 8);
  convert_flat(a.in[26], (u16*)(a.ws + OFF_KEY2), 8 * 128 * 128 / 8);
  s5_build(a, tile);
  rmsnorm_rows(a.in[0], a.in[1], (u16*)(a.ws + OFF_R1));
}

__device__ __forceinline__ void phase1(const KArgs& a, u16* lds) {
  const u16* hn = (const u16*)(a.ws + OFF_R1); const u16* W = (const u16*)(a.ws + OFF_WIN);
  u16* Up = (u16*)(a.ws + OFF_R6); u16* xm = (u16*)(a.ws + OFF_R2); u16* sz = (u16*)(a.ws + OFF_R3);
  u16* sga = (u16*)(a.ws + OFF_R4); u16* sgb = (u16*)(a.ws + OFF_R5); float* gif = (float*)(a.ws + OFF_GIF);
  constexpr int NTN = 30, NTILES = 128 * NTN;
  for (int t = blockIdx.x; t < NTILES; t += gridDim.x) {
    const int mg = t / (32 * NTN), rem = t % (32 * NTN); const int nt = rem / 32, mt = mg * 32 + rem % 32;
    const int m0 = mt * 256, n0 = nt * 256;
    f32x4 acc[4][8]; zero_acc<256, 256, 4, 2>(acc);
    mainloop1<256, 256, 4, 2, true>(lds, 2048, hn, [&](int r) { return (unsigned)(m0 + r) * 2048u; }, W, [&](int c) { return (unsigned)(n0 + c) * 2048u; }, acc);
    if (n0 < 512) {
      epilogue_t<256, 256, 4, 2>(acc, m0, n0, [&](int row, int col, f32x4 v) {
        const int g = col >> 4, hh = col & 15;
        *(uint2*)(Up + (size_t)g * 524288 + (size_t)(row >> 6) * 1024 + (row & 63) * 16 + hh) = pack4(v);
      });
    } else if (n0 < 2048) {
      epilogue_t<256, 256, 4, 2>(acc, m0, n0, [&](int row, int col, f32x4 v) { *(uint2*)(xm + (size_t)row * 1536 + col - 512) = pack4(v); });
    } else if (n0 < 3584) {
      epilogue_t<256, 256, 4, 2>(acc, m0, n0, [&](int row, int col, f32x4 v) {
        *(uint2*)(sz + (size_t)row * 1536 + col - 2048) = pack4((f32x4){sigm(v[0]), sigm(v[1]), sigm(v[2]), sigm(v[3])});
      });
    } else {
      u16* dst = n0 < 5632 ? sga : sgb; const int cb = n0 < 5632 ? 3584 : 5632;
      epilogue_t<256, 256, 4, 2>(acc, m0, n0, [&](int row, int col, f32x4 v) {
        *(uint2*)(dst + (size_t)row * 2048 + col - cb) = pack4((f32x4){sigm(v[0]), sigm(v[1]), sigm(v[2]), sigm(v[3])});
      });
    }
  }
  {
    const int lane = threadIdx.x & 63, l15 = lane & 15, quad = lane >> 4; const int gw = blockIdx.x * 8 + (threadIdx.x >> 6); const int nw = gridDim.x * 8;
    for (int rt = gw; rt < T / 16; rt += nw) {
      f32x4 acc = (f32x4){0.f, 0.f, 0.f, 0.f};
      const u16* ap = hn + (size_t)(rt * 16 + l15) * 2048 + quad * 8;
      const u16* bp = W + (size_t)(7680 + l15) * 2048 + quad * 8;
#pragma unroll 8
      for (int ks = 0; ks < 64; ++ks) {
        const bf16x8 fa = *(const bf16x8*)(ap + ks * 32), fb = *(const bf16x8*)(bp + ks * 32);
        acc = __builtin_amdgcn_mfma_f32_16x16x32_bf16(fa, fb, acc, 0, 0, 0);
      }
      if (l15 < 8) {
#pragma unroll
        for (int r = 0; r < 4; ++r) gif[(size_t)(rt * 16 + quad * 4 + r) * 8 + l15] = acc[r];
      }
    }
  }
}

__device__ __forceinline__ void phase2(const KArgs& a, u16* lds) {
  const int tid = threadIdx.x, lane = tid & 63, wave = tid >> 6;
  {
    const int gw = blockIdx.x * 8 + wave;
    if (gw < 64) {
      const int bh = gw, b = bh >> 2, h = bh & 3;
      const float* gif = (const float*)(a.ws + OFF_GIF);
      float* gG = (float*)(a.ws + OFF_GATES); float* gM = gG + T * 4; float* gInter = gM + T * 4; float* gEinv = gInter + T * 4;
      float* gWend = gEinv + T * 4; float* gDecay = gWend + T * 4;
      const float bi = a.in[17][h], bfv = a.in[18][h];
      float iv[32], fv[32];
#pragma unroll
      for (int c = 0; c < 32; ++c) { const size_t tok = (size_t)b * 2048 + c * 64 + lane; iv[c] = gif[tok * 8 + h]; fv[c] = gif[tok * 8 + 4 + h]; }
      float m_prev = 0.f;
#pragma unroll
      for (int c = 0; c < 32; ++c) {
        const float ii = iv[c] + bi, ff = fv[c] + bfv;
        const float lf = fminf(ff, 0.f) - log1pf(expf(-fabsf(ff)));
        float bc = lf;
#pragma unroll
        for (int o = 1; o < 64; o <<= 1) { float t2 = __shfl_up(bc, o); if (lane >= o) bc += t2; }
        const float g = ii - bc;
        float cm = g;
#pragma unroll
        for (int o = 1; o < 64; o <<= 1) { float t2 = __shfl_up(cm, o); if (lane >= o) cm = fmaxf(cm, t2); }
        const float M = fmaxf(m_prev, cm);
        const float ML = __shfl(M, 63), bl = __shfl(bc, 63);
        const size_t gi = (size_t)bh * 2048 + c * 64 + lane;
        gG[gi] = g; gM[gi] = M; gInter[gi] = expf(m_prev - M); gEinv[gi] = expf(-bc - M); gWend[gi] = expf(g - ML);
        if (lane == 0) gDecay[bh * 32 + c] = expf(m_prev - ML);
        m_prev = bl + ML;
      }
    }
  }
  {
    const u16* Up = (const u16*)(a.ws + OFF_R6); const u16* Mm = (const u16*)(a.ws + OFF_MMAT); float* V5 = (float*)(a.ws + OFF_V5);
    for (int t = blockIdx.x; t < 256; t += gridDim.x) {
      const int g = t >> 3, m0 = (t & 7) * 64;
      f32x4 acc[2][2]; zero_acc<64, 128, 2, 4>(acc);
      mainloop<64, 128, 2, 4>(lds, 1024, Up + (size_t)g * 524288, [&](int r) { return (unsigned)(m0 + r) * 1024u; }, Mm + (size_t)g * 131072, [&](int c) { return (unsigned)c * 1024u; }, acc);
      epilogue<64, 128, 2, 4>(acc, m0, 0, [&](int row, int col, f32x4 v) {
#pragma unroll
        for (int r = 0; r < 4; ++r) V5[((size_t)g * 512 + row + r) * 128 + col] = v[r];
      });
    }
  }
  {
    const u16* xm = (const u16*)(a.ws + OFF_R2); const u16* Wv = (const u16*)(a.ws + OFF_WV); u16* VT = (u16*)(a.ws + OFF_R7);
    for (int t = blockIdx.x; t < 1536; t += gridDim.x) {
      const int nt = t % 3, mt = (t / 3) % 128, h = t / 384;
      const int m0 = mt * 256, n0 = nt * 128;
      f32x4 acc[4][4]; zero_acc<256, 128, 4, 2>(acc);
      mainloop<256, 128, 4, 2>(lds, 384, xm + h * 384, [&](int r) { return (unsigned)(m0 + r) * 1536u; }, Wv + (size_t)(h * 384 + n0) * 384, [&](int c) { return (unsigned)c * 384u; }, acc);
      epilogue<256, 128, 4, 2>(acc, m0, n0, [&](int row, int col, f32x4 v) {
        const int b = row >> 11, c = (row >> 6) & 31, s = row & 63; const int cid = (b * 4 + h) * 32 + c;
        uint2 o; o.x = pack2(v[0], v[1]); o.y = pack2(v[2], v[3]);
        *(uint2*)(VT + ((((size_t)cid * 24 + (col >> 4)) * 2 + (s >> 5)) * 64 + (((s & 31) >> 3) * 16 + (col & 15))) * 8 + (s & 7)) = o;
      });
    }
  }
  {
    const u16* xm = (const u16*)(a.ws + OFF_R2); u16* xc = (u16*)(a.ws + OFF_R1);
    const float* cw = a.in[12]; const float* cb = a.in[13];
    const size_t n8 = (size_t)T * 192;
    for (size_t i = (size_t)blockIdx.x * NT + tid; i < n8; i += (size_t)gridDim.x * NT) {
      const int tok = (int)(i / 192), c8 = (int)(i % 192) * 8; const int s = tok & 2047;
      float o[8];
#pragma unroll
      for (int q = 0; q < 8; ++q) o[q] = cb[c8 + q];
#pragma unroll
      for (int j = 0; j < 4; ++j) {
        if (s - 3 + j >= 0) {
          uint4 v = *(const uint4*)(xm + (size_t)(tok - 3 + j) * 1536 + c8);
          const float* w = cw + j * 1536 + c8;
          o[0] += bflo(v.x) * w[0]; o[1] += bfhi(v.x) * w[1]; o[2] += bflo(v.y) * w[2]; o[3] += bfhi(v.y) * w[3];
          o[4] += bflo(v.z) * w[4]; o[5] += bfhi(v.z) * w[5]; o[6] += bflo(v.w) * w[6]; o[7] += bfhi(v.w) * w[7];
        }
      }
#pragma unroll
      for (int q = 0; q < 8; ++q) o[q] = o[q] * sigm(o[q]);
      uint4 r; r.x = pack2(o[0], o[1]); r.y = pack2(o[2], o[3]); r.z = pack2(o[4], o[5]); r.w = pack2(o[6], o[7]);
      *(uint4*)(xc + (size_t)tok * 1536 + c8) = r;
    }
  }
}

__device__ __forceinline__ void phase3(const KArgs& a, u16* lds) {
  const int tid = threadIdx.x;
  {
    const float* V5 = (const float*)(a.ws + OFF_V5); u16* X5 = (u16*)(a.ws + OFF_X5); const float* aL = (const float*)(a.ws + OFF_AL);
    for (int i = blockIdx.x * NT + tid; i < 32768; i += gridDim.x * NT) {
      const int p = i & 63, b = (i >> 6) & 15, g = i >> 10;
      const float lr = aL[(g * 64 + p) * 2], li = aL[(g * 64 + p) * 2 + 1];
      float xr = 0.f, xi = 0.f;
      for (int c = 0; c < 32; ++c) {
        const size_t idx = ((size_t)g * 512 + b * 32 + c) * 128;
        X5[idx + p] = f2bf(xr); X5[idx + 64 + p] = f2bf(xi);
        const float vr = V5[idx + p], vi = V5[idx + 64 + p];
        const float nr = lr * xr - li * xi + vr, ni = lr * xi + li * xr + vi;
        xr = nr; xi = ni;
      }
    }
  }
  {
    const u16* xc = (const u16*)(a.ws + OFF_R1);
    u16* Kn = (u16*)(a.ws + OFF_R2); u16* KT = (u16*)(a.ws + OFF_R9); u16* QF = (u16*)a.out;
    const u16* Wq = (const u16*)(a.ws + OFF_WQ);
    for (int t = blockIdx.x; t < 1536; t += gridDim.x) {
      const int nt = t % 3, mt = (t / 3) % 128, h = t / 384;
      const int m0 = mt * 256, n0 = nt * 256;
      f32x4 acc[4][8]; zero_acc<256, 256, 4, 2>(acc);
      mainloop1<256, 256, 4, 2>(lds, 384, xc + h * 384, [&](int r) { return (unsigned)(m0 + r) * 1536u; }, Wq,
          [&](int c) { const int col = n0 + c; return col < 384 ? (unsigned)(h * 384 + col) * 384u : 1048576u + (unsigned)(h * 384 + col - 384) * 384u; }, acc);
      epilogue<256, 256, 4, 2>(acc, m0, n0, [&](int row, int col768, f32x4 v) {
        if (col768 < 384) {
          const int col = col768;
#pragma unroll
          for (int r = 0; r < 4; ++r) {
            const u16 q16 = f2bf(v[r]); const int tk = row + r;
            const int b = tk >> 11, c = (tk >> 6) & 31, s = tk & 63; const int cid = (b * 4 + h) * 32 + c;
            QF[((((size_t)cid * 4 + (s >> 4)) * 12 + (col >> 5)) * 64 + (((col & 31) >> 3) * 16 + (s & 15))) * 8 + (col & 7)] = q16;
          }
        } else {
          const int col = col768 - 384;
#pragma unroll
          for (int r = 0; r < 4; ++r) Kn[(size_t)(row + r) * 1536 + h * 384 + col] = f2bf(v[r]);
          const int b = row >> 11, c = (row >> 6) & 31, s = row & 63; const int cid = (b * 4 + h) * 32 + c;
          uint2 o; o.x = pack2(v[0], v[1]); o.y = pack2(v[2], v[3]);
          *(uint2*)(KT + ((((size_t)cid * 24 + (col >> 4)) * 2 + (s >> 5)) * 64 + (((s & 31) >> 3) * 16 + (col & 15))) * 8 + (s & 7)) = o;
        }
      });
    }
  }
}

__device__ __forceinline__ void phase4(const KArgs& a, u16* lds) {
  const int tid = threadIdx.x, lane = tid & 63;
  {
    const u16* QF = (const u16*)a.out; const u16* Kn = (const u16*)(a.ws + OFF_R2); u16* SW = (u16*)(a.ws + OFF_R10);
    const float* gG = (const float*)(a.ws + OFF_GATES); const float* gM = gG + T * 4; float* gDen = (float*)(a.ws + OFF_GATES) + (size_t)T * 4 * 5 + 4096;
    float* dl = (float*)((unsigned char*)lds + GEMM_LDS);
    for (int cid = blockIdx.x; cid < 2048; cid += gridDim.x) {
      const int bh = cid >> 5, c = cid & 31, b = bh >> 2, h = bh & 3;
      const int t0 = b * 2048 + c * 64; const size_t gi = (size_t)bh * 2048 + c * 64;
      if (tid < 64) dl[tid] = 0.f;
      f32x4 acc[1][2]; zero_acc<64, 64, 4, 2>(acc);
      mainloop<64, 64, 4, 2, false, 16>(lds, 384, QF + (size_t)cid * 24576, [&](int r) { return (unsigned)(((r >> 4) * 768 + (r & 15)) * 8); }, Kn + (size_t)t0 * 1536 + h * 384, [&](int cc) { return (unsigned)cc * 1536u; }, acc);
      float ps[4] = {0.f, 0.f, 0.f, 0.f}; int prow = 0;
      epilogue<64, 64, 4, 2>(acc, 0, 0, [&](int row, int col, f32x4 v) {
        const float gs = gG[gi + col]; prow = row;
#pragma unroll
        for (int r = 0; r < 4; ++r) {
          const int tt = row + r;
          const float w = (col <= tt) ? v[r] * __expf(gs - gM[gi + tt]) : 0.f;
          SW[((((size_t)cid * 4 + (tt >> 4)) * 2 + (col >> 5)) * 64 + (((col & 31) >> 3) * 16 + (tt & 15))) * 8 + (col & 7)] = f2bf(w);
          ps[r] += w;
        }
      });
#pragma unroll
      for (int r = 0; r < 4; ++r) {
        float s = ps[r];
        s += __shfl_xor(s, 1); s += __shfl_xor(s, 2); s += __shfl_xor(s, 4); s += __shfl_xor(s, 8);
        if ((lane & 15) == 0) atomicAdd(&dl[prow + r], s);
      }
      __syncthreads();
      if (tid < 64) gDen[gi + tid] = dl[tid];
    }
  }
  {
    const u16* Up = (const u16*)(a.ws + OFF_R6); const u16* Km = (const u16*)(a.ws + OFF_KMAT); const u16* Em = (const u16*)(a.ws + OFF_EMAT);
    const u16* X5 = (const u16*)(a.ws + OFF_X5); u16* Yg = (u16*)(a.ws + OFF_R1 + 96 * MBy); const float* dsk = a.in[10];
    for (int t = blockIdx.x; t < 512; t += gridDim.x) {
      const int nt = t & 7, mt = (t >> 3) & 1, g = t >> 4;
      const int m0 = mt * 256, n0 = nt * 128;
      f32x4 acc[4][4]; zero_acc<256, 128, 4, 2>(acc);
      mainloop_gen<256, 128, 4, 2>(lds, n0 + 128,
          [&](int r, int k) { return Up + (size_t)g * 524288 + (size_t)(m0 + r) * 1024 + k; },
          [&](int c, int k) -> const u16* {
            const int n = n0 + c; const int j = n >> 4, hh = n & 15, s = k >> 4, h0 = k & 15;
            return s <= j ? Km + ((size_t)(g * 64 + (j - s)) * 16 + hh) * 16 + h0 : (const u16*)nullptr;
          }, acc);
      mainloop<256, 128, 4, 2>(lds, 128, X5 + ((size_t)g * 512 + m0) * 128, [&](int r) { return (unsigned)r * 128u; }, Em + ((size_t)g * 1024 + n0) * 128, [&](int c) { return (unsigned)c * 128u; }, acc);
      epilogue<256, 128, 4, 2>(acc, m0, n0, [&](int row, int col, f32x4 v) {
        const int j = col >> 4, hh = col & 15, ch = g * 16 + hh; const float dk = dsk[ch];
#pragma unroll
        for (int r = 0; r < 4; ++r) {
          const int rr = row + r;
          const float u = bf2f(Up[(size_t)g * 524288 + (size_t)rr * 1024 + j * 16 + hh]);
          Yg[((size_t)rr * 64 + j) * 512 + ch] = f2bf(gelu_t(v[r] + dk * u));
        }
      });
    }
  }
}

__device__ __forceinline__ void phase5(const KArgs& a, u16* lds) {
  const int tid = threadIdx.x, lane = tid & 63, wave = tid >> 6, l15 = lane & 15, quad = lane >> 4;
  const int dq = wave & 3, eh = wave >> 2;
  u16* Cl = lds; float* nl = (float*)(lds + 96 * 392); unsigned* pfl = (unsigned*)(lds + 96 * 392) + 1024;
  const u16* QF = (const u16*)a.out; const u16* KTF = (const u16*)(a.ws + OFF_R9); const u16* VTF = (const u16*)(a.ws + OFF_R7);
  const u16* SWF = (const u16*)(a.ws + OFF_R10); u16* hraw = (u16*)(a.ws + OFF_R2);
  const float* gG = (const float*)(a.ws + OFF_GATES); const float* gInter = gG + (size_t)T * 8; const float* gEinv = gG + (size_t)T * 12;
  const float* gWend = gG + (size_t)T * 16; const float* gDecay = gG + (size_t)T * 20; const float* gDen = gG + (size_t)T * 20 + 4096;
  for (int unit = blockIdx.x; unit < 256; unit += gridDim.x) {
    const int bh = gridDim.x == 256 ? (unit & 7) + 8 * (unit >> 5) : unit >> 2, j = gridDim.x == 256 ? (unit >> 3) & 3 : unit & 3, b = bh >> 2, h = bh & 3;
    f32x4 Ct[6][4];
#pragma unroll
    for (int di = 0; di < 6; ++di)
#pragma unroll
      for (int ei = 0; ei < 4; ++ei) Ct[di][ei] = (f32x4){0.f, 0.f, 0.f, 0.f};
    unsigned pf = 0u;
    for (int c = 0; c < 32; ++c) {
      const int cid = bh * 32 + c, t0 = b * 2048 + c * 64; const size_t gi = (size_t)bh * 2048 + c * 64;
      pfl[tid] = pf;
#pragma unroll
      for (int di = 0; di < 6; ++di) {
#pragma unroll
        for (int ei = 0; ei < 3; ++ei) {
          const int e = eh * 48 + ei * 16 + l15, d = dq * 96 + di * 16 + quad * 4;
          uint2 o; o.x = pack2(Ct[di][ei][0], Ct[di][ei][1]); o.y = pack2(Ct[di][ei][2], Ct[di][ei][3]);
          *(uint2*)(Cl + e * 392 + d) = o;
        }
        if (eh == 0 && l15 == 0) *(f32x4*)(nl + dq * 96 + di * 16 + quad * 4) = Ct[di][3];
      }
      asm volatile("s_waitcnt lgkmcnt(0)\n\ts_barrier" ::: "memory");
      const int tt = wave & 3, eg = wave >> 2;
      f32x4 aqc[3], asv[3];
#pragma unroll
      for (int ej = 0; ej < 3; ++ej) { aqc[ej] = (f32x4){0.f, 0.f, 0.f, 0.f}; asv[ej] = (f32x4){0.f, 0.f, 0.f, 0.f}; }
      float qnp = 0.f;
      {
        const u16* qf = QF + ((size_t)(cid * 4 + tt) * 12) * 512 + lane * 8;
#pragma unroll 2
        for (int ks = 0; ks < 12; ++ks) {
          const bf16x8 fa = *(const bf16x8*)(qf + ks * 512);
#pragma unroll
          for (int ej = 0; ej < 3; ++ej) {
            const bf16x8 fb = *(const bf16x8*)(Cl + (eg * 48 + ej * 16 + l15) * 392 + ks * 32 + quad * 8);
            aqc[ej] = __builtin_amdgcn_mfma_f32_16x16x32_bf16(fa, fb, aqc[ej], 0, 0, 0);
          }
          const f32x4 n0 = *(const f32x4*)(nl + ks * 32 + quad * 8), n1 = *(const f32x4*)(nl + ks * 32 + quad * 8 + 4);
#pragma unroll
          for (int i = 0; i < 4; ++i) qnp += bf2f((u16)fa[i]) * n0[i] + bf2f((u16)fa[4 + i]) * n1[i];
        }
        qnp += __shfl_xor(qnp, 16); qnp += __shfl_xor(qnp, 32);
        const u16* swf = SWF + ((size_t)(cid * 4 + tt) * 2) * 512 + lane * 8;
#pragma unroll
        for (int ks = 0; ks < 2; ++ks) {
          const bf16x8 fa = *(const bf16x8*)(swf + ks * 512);
#pragma unroll
          for (int ej = 0; ej < 3; ++ej) {
            const bf16x8 fb = *(const bf16x8*)(VTF + (((size_t)cid * 24 + (j * 6 + eg * 3 + ej)) * 2 + ks) * 512 + lane * 8);
            asv[ej] = __builtin_amdgcn_mfma_f32_16x16x32_bf16(fa, fb, asv[ej], 0, 0, 0);
          }
        }
#pragma unroll
        for (int r = 0; r < 4; ++r) {
          const int t = tt * 16 + quad * 4 + r;
          const float qn = __shfl(qnp, quad * 4 + r);
          const float inter = gInter[gi + t];
          const float dn = gDen[gi + t] + inter * qn;
          const float inv = 1.f / fmaxf(fabsf(dn), gEinv[gi + t]);
#pragma unroll
          for (int ej = 0; ej < 3; ++ej)
            hraw[(size_t)(t0 + t) * 1536 + h * 384 + j * 96 + eg * 48 + ej * 16 + l15] = f2bf((asv[ej][r] + inter * aqc[ej][r]) * inv);
        }
      }
      const float decay = gDecay[cid];
      asm volatile("s_waitcnt lgkmcnt(0)\n\ts_barrier" ::: "memory");
      pf = 0u;
      if (c + 1 < 32) {
        const int nc = cid + 1;
        if (tid < 384) { pf ^= *(const unsigned*)(QF + (size_t)nc * 24576 + tid * 64); pf ^= *(const unsigned*)(KTF + (size_t)nc * 24576 + tid * 64); }
        if (tid < 96) pf ^= *(const unsigned*)(VTF + ((size_t)nc * 24 + j * 6) * 1024 + tid * 64);
        if (tid < 64) pf ^= *(const unsigned*)(SWF + (size_t)nc * 4096 + tid * 64);
      }
#pragma unroll
      for (int di = 0; di < 6; ++di)
#pragma unroll
        for (int ei = 0; ei < 4; ++ei) Ct[di][ei] *= decay;
#pragma unroll
      for (int ks = 0; ks < 2; ++ks) {
        const float* wp = gWend + gi + ks * 32 + quad * 8;
        const float4 w0 = *(const float4*)wp, w1 = *(const float4*)(wp + 4);
        bf16x8 fb[4];
#pragma unroll
        for (int ei = 0; ei < 3; ++ei) {
          const uint4 v = *(const uint4*)(VTF + (((size_t)cid * 24 + (j * 6 + eh * 3 + ei)) * 2 + ks) * 512 + lane * 8);
          uint4 o;
          o.x = pack2(bflo(v.x) * w0.x, bfhi(v.x) * w0.y); o.y = pack2(bflo(v.y) * w0.z, bfhi(v.y) * w0.w);
          o.z = pack2(bflo(v.z) * w1.x, bfhi(v.z) * w1.y); o.w = pack2(bflo(v.w) * w1.z, bfhi(v.w) * w1.w);
          fb[ei] = *(bf16x8*)&o;
        }
        {
          uint4 o = make_uint4(0, 0, 0, 0);
          if (l15 == 0) { o.x = pack2(w0.x, w0.y); o.y = pack2(w0.z, w0.w); o.z = pack2(w1.x, w1.y); o.w = pack2(w1.z, w1.w); }
          fb[3] = *(bf16x8*)&o;
        }
#pragma unroll
        for (int di = 0; di < 6; ++di) {
          const bf16x8 fa = *(const bf16x8*)(KTF + (((size_t)cid * 24 + (dq * 6 + di)) * 2 + ks) * 512 + lane * 8);
#pragma unroll
          for (int ei = 0; ei < 3; ++ei) Ct[di][ei] = __builtin_amdgcn_mfma_f32_16x16x32_bf16(fa, fb[ei], Ct[di][ei], 0, 0, 0);
          if (eh == 0) Ct[di][3] = __builtin_amdgcn_mfma_f32_16x16x32_bf16(fa, fb[3], Ct[di][3], 0, 0, 0);
        }
      }
    }
    __syncthreads();
  }
}

__device__ __forceinline__ void phase6(const KArgs& a) {
  const int lane = threadIdx.x & 63; const int gw = blockIdx.x * 8 + (threadIdx.x >> 6); const int nw = gridDim.x * 8;
  const u16* hraw = (const u16*)(a.ws + OFF_R2); const u16* sz = (const u16*)(a.ws + OFF_R3); const u16* xc = (const u16*)(a.ws + OFF_R1);
  u16* Hn = (u16*)(a.ws + OFF_R7); const float* gain = a.in[19]; const float* skip = a.in[20];
  for (int it = gw; it < T * 4; it += nw) {
    const int tok = it >> 2, h = it & 3; const size_t base = (size_t)tok * 1536 + h * 384;
    float v[6]; float s = 0.f;
#pragma unroll
    for (int i = 0; i < 6; ++i) { v[i] = bf2f(hraw[base + lane + i * 64]) * bf2f(sz[base + lane + i * 64]); s += v[i]; }
    const float mu = wave_sum(s) * (1.f / 384.f);
    float q = 0.f;
#pragma unroll
    for (int i = 0; i < 6; ++i) { v[i] -= mu; q += v[i] * v[i]; }
    const float rs = rsqrtf(wave_sum(q) * (1.f / 384.f) + 1e-6f);
#pragma unroll
    for (int i = 0; i < 6; ++i) {
      const int e = h * 384 + lane + i * 64;
      Hn[base + lane + i * 64] = f2bf(v[i] * rs * gain[e] + skip[e] * bf2f(xc[base + lane + i * 64]));
    }
  }
}

__device__ __forceinline__ void phase7a(const KArgs& a, u16* lds) {
  const u16* Yg = (const u16*)(a.ws + OFF_R1 + 96 * MBy); const u16* Wg = (const u16*)(a.ws + OFF_WGLU);
  const u16* sga = (const u16*)(a.ws + OFF_R4); u16* ya = (u16*)a.out;
  for (int t = blockIdx.x; t < 2048; t += gridDim.x) {
    const int grp = t / 512, rem = t % 512; const int nq = rem / 32, mt = grp * 32 + rem % 32;
    const int m0 = mt * 256;
    f32x4 acc[4][8]; zero_acc<256, 256, 4, 2>(acc);
    mainloop1<256, 256, 4, 2, true>(lds, 512, Yg, [&](int r) { return (unsigned)(m0 + r) * 512u; }, Wg,
        [&](int c) { const int j = c >> 4; return (unsigned)(((j & 1) ? 2048 : 0) + nq * 128 + (j >> 1) * 16 + (c & 15)) * 512u; }, acc);
    const int lane = threadIdx.x & 63, wave = threadIdx.x >> 6; const int wm = wave % 4, wn = wave / 4; const int l15 = lane & 15, quad = lane >> 4;
#pragma unroll
    for (int i = 0; i < 4; ++i)
#pragma unroll
      for (int jj = 0; jj < 4; ++jj) {
        const int row = m0 + wm * 64 + i * 16 + l15, col = nq * 128 + (wn * 4 + jj) * 16 + quad * 4;
        const size_t idx = (size_t)row * 2048 + col;
        const uint2 g2 = *(const uint2*)(sga + idx);
        f32x4 o;
        o[0] = acc[i][2 * jj][0] * sigm(acc[i][2 * jj + 1][0]) * bflo(g2.x); o[1] = acc[i][2 * jj][1] * sigm(acc[i][2 * jj + 1][1]) * bfhi(g2.x);
        o[2] = acc[i][2 * jj][2] * sigm(acc[i][2 * jj + 1][2]) * bflo(g2.y); o[3] = acc[i][2 * jj][3] * sigm(acc[i][2 * jj + 1][3]) * bfhi(g2.y);
        *(uint2*)(ya + idx) = pack4(o);
      }
  }
}
__device__ __forceinline__ void phase7b(const KArgs& a, u16* lds) {
  const u16* Hn = (const u16*)(a.ws + OFF_R7); const u16* Wm = (const u16*)(a.ws + OFF_WMO);
  const u16* sgb = (const u16*)(a.ws + OFF_R5); const u16* ya = (const u16*)a.out; u16* mg = (u16*)(a.ws + OFF_R8);
  for (int t = blockIdx.x; t < 1024; t += gridDim.x) {
    const int grp = t / 256, rem = t % 256; const int nt = rem / 32, mt = grp * 32 + rem % 32;
    const int m0 = mt * 256, n0 = nt * 256;
    f32x4 acc[4][8]; zero_acc<256, 256, 4, 2>(acc);
    mainloop1<256, 256, 4, 2, true>(lds, 1536, Hn, [&](int r) { return (unsigned)(m0 + r) * 1536u; }, Wm, [&](int c) { return (unsigned)(n0 + c) * 1536u; }, acc);
    epilogue_t<256, 256, 4, 2>(acc, m0, n0, [&](int row, int col, f32x4 v) {
      const size_t idx = (size_t)row * 2048 + col;
      const uint2 y2 = *(const uint2*)(ya + idx), g2 = *(const uint2*)(sgb + idx);
      *(uint2*)(mg + idx) = pack4((f32x4){bflo(y2.x) + bflo(g2.x) * v[0], bfhi(y2.x) + bfhi(g2.x) * v[1], bflo(y2.y) + bflo(g2.y) * v[2], bfhi(y2.y) + bfhi(g2.y) * v[3]});
    });
  }
}

__device__ __forceinline__ void phase8(const KArgs& a, u16* lds) {
  const u16* mg = (const u16*)(a.ws + OFF_R8); const u16* W = (const u16*)(a.ws + OFF_WOUT); const float* x = a.in[0]; u16* h1b = (u16*)(a.ws + OFF_H1B);
  for (int t = blockIdx.x; t < 1024; t += gridDim.x) {
    const int grp = t / 256, rem = t % 256; const int nt = rem / 32, mt = grp * 32 + rem % 32;
    const int m0 = mt * 256, n0 = nt * 256;
    f32x4 acc[4][8]; zero_acc<256, 256, 4, 2>(acc);
    mainloop1<256, 256, 4, 2, true>(lds, 2048, mg, [&](int r) { return (unsigned)(m0 + r) * 2048u; }, W, [&](int c) { return (unsigned)(n0 + c) * 2048u; }, acc);
    epilogue_t<256, 256, 4, 2>(acc, m0, n0, [&](int row, int col, f32x4 v) {
      const size_t idx = (size_t)row * 2048 + col;
      const float4 xv = *(const float4*)(x + idx);
      *(uint2*)(h1b + idx) = pack4((f32x4){xv.x + v[0], xv.y + v[1], xv.z + v[2], xv.w + v[3]});
    });
  }
}

__device__ __forceinline__ void phase9(const KArgs& a) {
  {
    const int lane = threadIdx.x & 63; const int gw = blockIdx.x * 8 + (threadIdx.x >> 6); const int nw = gridDim.x * 8;
    const u16* src = (const u16*)(a.ws + OFF_H1B); const float* g = a.in[23]; u16* dst = (u16*)(a.ws + OFF_R1);
    unsigned char* t8 = a.ws + OFF_R7; float* tsc = (float*)(a.ws + OFF_R7 + 64 * MBy);
    for (int r = gw; r < T; r += nw) {
      const uint2* p = (const uint2*)(src + (size_t)r * D);
      float4 v[8]; float ss = 0.f;
#pragma unroll
      for (int i = 0; i < 8; ++i) { const uint2 w = p[lane + i * 64]; v[i] = make_float4(bflo(w.x), bfhi(w.x), bflo(w.y), bfhi(w.y)); ss += v[i].x * v[i].x + v[i].y * v[i].y + v[i].z * v[i].z + v[i].w * v[i].w; }
      ss = wave_sum(ss);
      const float rs = rsqrtf(ss * (1.f / D) + 1e-6f);
      float mx = 0.f;
#pragma unroll
      for (int i = 0; i < 8; ++i) {
        const float4 gg = ((const float4*)g)[lane + i * 64];
        v[i].x *= rs * gg.x; v[i].y *= rs * gg.y; v[i].z *= rs * gg.z; v[i].w *= rs * gg.w;
        mx = fmaxf(mx, fmaxf(fmaxf(fabsf(v[i].x), fabsf(v[i].y)), fmaxf(fabsf(v[i].z), fabsf(v[i].w))));
        uint2 o; o.x = pack2(v[i].x, v[i].y); o.y = pack2(v[i].z, v[i].w);
        ((uint2*)(dst + (size_t)r * D))[lane + i * 64] = o;
      }
      mx = wave_maxf(mx);
      const float sc = mx > 0.f ? 224.f / mx : 1.f;
      if (lane == 0) tsc[r] = 1.f / sc;
#pragma unroll
      for (int i = 0; i < 8; ++i) ((unsigned*)(t8 + (size_t)r * D))[lane + i * 64] = pk4_fp8(v[i], sc);
    }
  }
  convert_fp8_rows(a.in[27], a.ws + OFF_R2, (float*)(a.ws + OFF_ESC), 16384);
  convert_fp8_rows(a.in[28], a.ws + OFF_R2 + 32 * MBy, (float*)(a.ws + OFF_ESC) + 16384, 16384);
}

__device__ __forceinline__ void phase10(const KArgs& a, u16* lds) {
  const u16* hn2 = (const u16*)(a.ws + OFF_R1); const u16* W = (const u16*)(a.ws + OFF_WQRY); u16* qr = (u16*)(a.ws + OFF_R8);
  for (int t = blockIdx.x; t < 1024; t += gridDim.x) {
    const int grp = t / 256, rem = t % 256; const int nt = rem / 32, mt = grp * 32 + rem % 32;
    const int m0 = mt * 256, n0 = nt * 256;
    f32x4 acc[4][8]; zero_acc<256, 256, 4, 2>(acc);
    mainloop1<256, 256, 4, 2, true>(lds, 2048, hn2, [&](int r) { return (unsigned)(m0 + r) * 2048u; }, W, [&](int c) { return (unsigned)(n0 + c) * 2048u; }, acc);
    epilogue_t<256, 256, 4, 2>(acc, m0, n0, [&](int row, int col, f32x4 v) { *(uint2*)(qr + (size_t)row * 2048 + col) = pack4(v); });
  }
}

__device__ __forceinline__ void phase11(const KArgs& a, u16* lds) {
  const u16* qr = (const u16*)(a.ws + OFF_R8); float* sc = (float*)(a.ws + OFF_R4);
  for (int t = blockIdx.x; t < 2048; t += gridDim.x) {
    const int hw = t / 128, mt = t % 128; const int h = hw >> 1, which = hw & 1;
    const int m0 = mt * 256;
    const u16* Kb = (const u16*)(a.ws + (which ? OFF_KEY2 : OFF_KEY1)) + (size_t)h * 16384;
    f32x4 acc[4][4]; zero_acc<256, 128, 4, 2>(acc);
    mainloop<256, 128, 4, 2, true>(lds, 128, qr + h * 256 + which * 128, [&](int r) { return (unsigned)(m0 + r) * 2048u; }, Kb, [&](int c) { return (unsigned)c * 128u; }, acc);
    epilogue_t<256, 128, 4, 2>(acc, m0, 0, [&](int row, int col, f32x4 v) { *(f32x4*)(sc + (size_t)row * 2048 + h * 256 + which * 128 + col) = v; });
  }
}

constexpr size_t OFF_EIDX = 932 * MBy, OFF_GATE = 940 * MBy, OFF_ACT = 956 * MBy, OFF_T8 = OFF_R7, OFF_TSC = OFF_R7 + 64 * MBy;

__device__ __forceinline__ unsigned wave_maxu_dpp(unsigned v) {
  unsigned t;
  t = (unsigned)__builtin_amdgcn_update_dpp(0, (int)v, 0x121, 0xf, 0xf, false); v = t > v ? t : v;
  t = (unsigned)__builtin_amdgcn_update_dpp(0, (int)v, 0x122, 0xf, 0xf, false); v = t > v ? t : v;
  t = (unsigned)__builtin_amdgcn_update_dpp(0, (int)v, 0x124, 0xf, 0xf, false); v = t > v ? t : v;
  t = (unsigned)__builtin_amdgcn_update_dpp(0, (int)v, 0x128, 0xf, 0xf, false); v = t > v ? t : v;
  const unsigned a0 = (unsigned)__builtin_amdgcn_readlane((int)v, 0), a1 = (unsigned)__builtin_amdgcn_readlane((int)v, 16);
  const unsigned a2 = (unsigned)__builtin_amdgcn_readlane((int)v, 32), a3 = (unsigned)__builtin_amdgcn_readlane((int)v, 48);
  const unsigned m0 = a0 > a1 ? a0 : a1, m1 = a2 > a3 ? a2 : a3;
  return m0 > m1 ? m0 : m1;
}
__device__ __forceinline__ float rdlane_f(float v, int l) { return __int_as_float(__builtin_amdgcn_readlane(__float_as_int(v), l)); }

__device__ __forceinline__ int mbcnt64(unsigned long long m) { return __builtin_amdgcn_mbcnt_hi((unsigned)(m >> 32), __builtin_amdgcn_mbcnt_lo((unsigned)m, 0)); }
__device__ __forceinline__ float wave_maxf_dpp(float v) {
  float t;
  t = __int_as_float(__builtin_amdgcn_update_dpp(0, __float_as_int(v), 0x121, 0xf, 0xf, false)); v = fmaxf(v, t);
  t = __int_as_float(__builtin_amdgcn_update_dpp(0, __float_as_int(v), 0x122, 0xf, 0xf, false)); v = fmaxf(v, t);
  t = __int_as_float(__builtin_amdgcn_update_dpp(0, __float_as_int(v), 0x124, 0xf, 0xf, false)); v = fmaxf(v, t);
  t = __int_as_float(__builtin_amdgcn_update_dpp(0, __float_as_int(v), 0x128, 0xf, 0xf, false)); v = fmaxf(v, t);
  return fmaxf(fmaxf(rdlane_f(v, 0), rdlane_f(v, 16)), fmaxf(rdlane_f(v, 32), rdlane_f(v, 48)));
}

__device__ __forceinline__ float keyval(unsigned k, unsigned lowmask) {
  k &= ~lowmask;
  return __uint_as_float((k & 0x80000000u) ? (k & 0x7fffffffu) : ~k);
}
__device__ __forceinline__ void ins16(unsigned (&arr)[16], unsigned x) {
#pragma unroll
  for (int j = 0; j < 16; ++j) { const unsigned hi = arr[j] > x ? arr[j] : x; x = arr[j] > x ? x : arr[j]; arr[j] = hi; }
}
__device__ __forceinline__ unsigned sel16(const unsigned (&arr)[16], int idx) {
  unsigned r = arr[0];
#pragma unroll
  for (int j = 1; j < 16; ++j) r = (idx == j) ? arr[j] : r;
  return r;
}

__device__ __forceinline__ void phase12(const KArgs& a, unsigned char* ldsb) {
  const int lane = threadIdx.x & 63, wave = threadIdx.x >> 6; const int gw = blockIdx.x * 8 + wave; const int nw = gridDim.x * 8;
  const float* sc = (const float*)(a.ws + OFF_R4);
  u16* eidx = (u16*)(a.ws + OFF_EIDX); float* gates = (float*)(a.ws + OFF_GATE);
  unsigned* buf = (unsigned*)ldsb + wave * (64 * 33);
  const int lr = lane >> 3, lc = lane & 7;
  for (int task = gw; task < T * 8 / 64; task += nw) {
    const size_t item0 = (size_t)task * 64;
    unsigned a1[16], a2[16];
#pragma unroll
    for (int j = 0; j < 16; ++j) { a1[j] = 0u; a2[j] = 0u; }
    auto build = [&](unsigned (&arr)[16], const int w) {
#pragma unroll 1
      for (int ch = 0; ch < 4; ++ch) {
        f32x4 v[8];
#pragma unroll
        for (int p = 0; p < 8; ++p) v[p] = *(const f32x4*)(sc + (item0 + lr + 8 * p) * 256 + w * 128 + ch * 32 + lc * 4);
#pragma unroll
        for (int p = 0; p < 8; ++p) {
          unsigned* d = buf + (lr + 8 * p) * 33 + lc * 4;
          d[0] = __float_as_uint(v[p][0]); d[1] = __float_as_uint(v[p][1]); d[2] = __float_as_uint(v[p][2]); d[3] = __float_as_uint(v[p][3]);
        }
#pragma unroll
        for (int e = 0; e < 32; ++e) {
          const float x = __uint_as_float(buf[lane * 33 + e]);
          ins16(arr, (ordkey(x) & ~127u) | (unsigned)(127 - (ch * 32 + e)));
        }
      }
    };
    build(a1, 0);
    build(a2, 1);
    unsigned* kb = buf + lane * 33;
#pragma unroll
    for (int j = 0; j < 16; ++j) { kb[j] = a1[j]; kb[16 + j] = a2[j]; }
    float v2[16];
#pragma unroll
    for (int j = 0; j < 16; ++j) v2[j] = keyval(a2[j], 127u);
    unsigned c[16];
#pragma unroll
    for (int j = 0; j < 16; ++j) c[j] = 0u;
#pragma unroll 1
    for (int ai = 0; ai < 16; ++ai) {
      const float va = keyval(kb[ai], 127u);
#pragma unroll
      for (int bi = 0; bi < 16; ++bi) ins16(c, (ordkey(va + v2[bi]) & ~255u) | (unsigned)(255 - (ai * 16 + bi)));
    }
    const float mx = keyval(c[0], 255u);
    float ev[16]; float es = 0.f; unsigned ex[16];
#pragma unroll
    for (int j = 0; j < 16; ++j) {
      ev[j] = __expf(keyval(c[j], 255u) - mx); es += ev[j];
      const int ci = 255 - (int)(c[j] & 255u);
      const unsigned k1 = kb[ci >> 4], k2 = kb[16 + (ci & 15)];
      ex[j] = (127u - (k1 & 127u)) * 128u + (127u - (k2 & 127u));
    }
    const float inv = 1.f / es;
    const size_t ob = (item0 + lane) * 16;
    uint4 o0, o1;
    o0.x = ex[0] | (ex[1] << 16); o0.y = ex[2] | (ex[3] << 16); o0.z = ex[4] | (ex[5] << 16); o0.w = ex[6] | (ex[7] << 16);
    o1.x = ex[8] | (ex[9] << 16); o1.y = ex[10] | (ex[11] << 16); o1.z = ex[12] | (ex[13] << 16); o1.w = ex[14] | (ex[15] << 16);
    *(uint4*)(eidx + ob) = o0; *(uint4*)(eidx + ob + 8) = o1;
#pragma unroll
    for (int q = 0; q < 4; ++q) *(float4*)(gates + ob + q * 4) = make_float4(ev[q * 4] * inv, ev[q * 4 + 1] * inv, ev[q * 4 + 2] * inv, ev[q * 4 + 3] * inv);
  }
}

__device__ __forceinline__ void flush_rows(const float* stg, u16* dstbase, size_t rowlen, int tok0, int tstride, int nslot, int coloff) {
  const int lane = threadIdx.x & 63;
#pragma unroll
  for (int k = 0; k < 8; ++k) {
    const int idx = k * 64 + lane; const int slot = idx >> 5, off = idx & 31;
    if (slot < nslot) {
      const float4 v = ((const float4*)stg)[idx];
      uint2 o; o.x = pack2(v.x, v.y); o.y = pack2(v.z, v.w);
      *(uint2*)(dstbase + (size_t)(tok0 + slot * tstride) * rowlen + coloff + off * 4) = o;
    }
  }
}

__device__ __forceinline__ void phase13(const KArgs& a, unsigned char* ldsb, const int emask = 0xffff) {
  const int lane = threadIdx.x & 63, wave = threadIdx.x >> 6, l15 = lane & 15, quad = lane >> 4;
  const int lr = lane >> 3, lc = lane & 7;
  const u16* eidx = (const u16*)(a.ws + OFF_EIDX); const unsigned char* Eu8 = a.ws + OFF_R2; const unsigned char* t8 = a.ws + OFF_T8;
  u16* partial = (u16*)(a.ws + OFF_R4);
  float* stg = (float*)ldsb + wave * 2048;
  unsigned char* tb = ldsb + 65536 + wave * 9216;
  const XInfo xinf = xinfo(a); const int lb = xinf.lb, nlb = xinf.nlb; const int tstride = nlb * 8;
  {
    int tok = lb * 8 + wave;
    int e[16];
    {
      const int t0 = tok < T ? tok : T - 1;
#pragma unroll
      for (int i = 0; i < 16; ++i) e[i] = eidx[(size_t)t0 * 128 + i * 8 + lr] & emask;
    }
    int j = 0, tok0 = tok;
    for (; tok < T; tok += tstride) {
      f32x4 accs[2][4];
#pragma unroll
      for (int hh = 0; hh < 2; ++hh)
#pragma unroll
        for (int g4 = 0; g4 < 4; ++g4) accs[hh][g4] = (f32x4){0.f, 0.f, 0.f, 0.f};
      for (int sl = xinf.xi; sl < 16; sl += xinf.np) {
        const unsigned char* ubase = Eu8 + (size_t)sl * (16384 * 128) + lc * 16;
        u32x4 rr[16];
#pragma unroll
        for (int i = 0; i < 16; ++i) rr[i] = *(const u32x4*)(ubase + (size_t)e[i] * 128);
        const u32x4* bp = (const u32x4*)(t8 + (size_t)tok * 2048 + (size_t)sl * 128 + quad * 32);
        const u32x4 b0 = bp[0], b1 = bp[1];
        const long bk[4] = {(long)(((unsigned long)b0[1] << 32) | b0[0]), (long)(((unsigned long)b0[3] << 32) | b0[2]),
                            (long)(((unsigned long)b1[1] << 32) | b1[0]), (long)(((unsigned long)b1[3] << 32) | b1[2])};
#pragma unroll
        for (int half = 0; half < 2; ++half) {
#pragma unroll
          for (int i = 0; i < 8; ++i) *(u32x4*)(tb + (i * 8 + lr) * 144 + lc * 16) = rr[half * 8 + i];
#pragma unroll
          for (int g4 = 0; g4 < 4; ++g4) {
            const u32x4* ap = (const u32x4*)(tb + (g4 * 16 + l15) * 144 + quad * 32);
            const u32x4 a0 = ap[0], a1 = ap[1];
            const long ak[4] = {(long)(((unsigned long)a0[1] << 32) | a0[0]), (long)(((unsigned long)a0[3] << 32) | a0[2]),
                                (long)(((unsigned long)a1[1] << 32) | a1[0]), (long)(((unsigned long)a1[3] << 32) | a1[2])};
#pragma unroll
            for (int ks = 0; ks < 4; ++ks) accs[half][g4] = __builtin_amdgcn_mfma_f32_16x16x32_fp8_fp8(ak[ks], bk[ks], accs[half][g4], 0, 0, 0);
          }
        }
      }
      {
        const int ntok = tok + tstride < T ? tok + tstride : T - 1;
#pragma unroll
        for (int i = 0; i < 16; ++i) e[i] = eidx[(size_t)ntok * 128 + i * 8 + lr] & emask;
      }
      if (l15 == 0) {
#pragma unroll
        for (int hh = 0; hh < 2; ++hh)
#pragma unroll
          for (int g4 = 0; g4 < 4; ++g4) *(f32x4*)(stg + j * 128 + (hh * 4 + g4) * 16 + quad * 4) = accs[hh][g4];
      }
      if (++j == 16) { flush_rows(stg, partial + (size_t)xinf.xi * T * 128, 128, tok0, tstride, 16, 0); j = 0; tok0 = tok + tstride; }
    }
    if (j) flush_rows(stg, partial + (size_t)xinf.xi * T * 128, 128, tok0, tstride, j, 0);
  }
}

__device__ __forceinline__ void phase14(const KArgs& a) {
  const u16* partial = (const u16*)(a.ws + OFF_R4); const u16* eidx = (const u16*)(a.ws + OFF_EIDX);
  const float* gates = (const float*)(a.ws + OFF_GATE); float* act = (float*)(a.ws + OFF_ACT);
  const float* esc = (const float*)(a.ws + OFF_ESC); const float* tsc = (const float*)(a.ws + OFF_TSC);
  const int npx = xinfo(a).np;
  for (size_t i = (size_t)blockIdx.x * NT + threadIdx.x; i < (size_t)T * 128; i += (size_t)gridDim.x * NT) {
    float s = 0.f;
#pragma unroll
    for (int sl = 0; sl < 16; ++sl) if (sl < npx) s += bf2f(partial[(size_t)sl * T * 128 + i]);
    const int e = eidx[i]; const int tok = (int)(i >> 7);
    const float d = s * esc[e] * tsc[tok];
    act[i] = gelu_t(d) * gates[i] * esc[16384 + e];
  }
}

__device__ __forceinline__ void phase15(const KArgs& a, unsigned char* ldsb) {
  const int lane = threadIdx.x & 63, wave = threadIdx.x >> 6, c16 = lane & 15, esub = lane >> 4;
  const u16* eidx = (const u16*)(a.ws + OFF_EIDX); const float* act = (const float*)(a.ws + OFF_ACT);
  const unsigned char* Ev8 = a.ws + OFF_R2 + 32 * MBy; u16* po = (u16*)(a.ws + OFF_R5);
  uint2* ent = (uint2*)ldsb + wave * 128;
  float* stg = (float*)(ldsb + 8192) + wave * 2048;
  const XInfo xinf = xinfo(a); const int lb = xinf.lb, nlb = xinf.nlb; const int tstride = nlb * 8;
  for (int sl = xinf.xi; sl < 16; sl += xinf.np) {
    const unsigned char* vbase = Ev8 + (size_t)sl * (16384 * 128) + c16 * 8;
    int j = 0, tok0 = lb * 8 + wave;
    for (int tok = lb * 8 + wave; tok < T; tok += tstride) {
      {
        const unsigned ee = *(const unsigned*)(eidx + (size_t)tok * 128 + lane * 2);
        const float2 aa = *(const float2*)(act + (size_t)tok * 128 + lane * 2);
        uint4 w; w.x = (ee & 0xffffu) * 128u; w.y = __float_as_uint(aa.x); w.z = (ee >> 16) * 128u; w.w = __float_as_uint(aa.y);
        *(uint4*)(ent + lane * 2) = w;
      }
      asm volatile("" ::: "memory");
      uint2 vv[32]; float av[32];
#pragma unroll
      for (int i = 0; i < 32; ++i) {
        const uint2 en = ent[i * 4 + esub];
        vv[i] = *(const uint2*)(vbase + en.x); av[i] = __uint_as_float(en.y);
      }
      f32x2 o2[4];
#pragma unroll
      for (int k = 0; k < 4; ++k) o2[k] = (f32x2){0.f, 0.f};
#pragma unroll
      for (int i = 0; i < 32; ++i) {
        const f32x2 p0 = __builtin_amdgcn_cvt_pk_f32_fp8((int)vv[i].x, false), p1 = __builtin_amdgcn_cvt_pk_f32_fp8((int)vv[i].x, true);
        const f32x2 p2 = __builtin_amdgcn_cvt_pk_f32_fp8((int)vv[i].y, false), p3 = __builtin_amdgcn_cvt_pk_f32_fp8((int)vv[i].y, true);
        const f32x2 a2 = (f32x2){av[i], av[i]};
        o2[0] = __builtin_elementwise_fma(a2, p0, o2[0]); o2[1] = __builtin_elementwise_fma(a2, p1, o2[1]);
        o2[2] = __builtin_elementwise_fma(a2, p2, o2[2]); o2[3] = __builtin_elementwise_fma(a2, p3, o2[3]);
      }
      float o[8] = {o2[0][0], o2[0][1], o2[1][0], o2[1][1], o2[2][0], o2[2][1], o2[3][0], o2[3][1]};
#pragma unroll
      for (int k = 0; k < 8; ++k) { o[k] += __shfl_xor(o[k], 16); o[k] += __shfl_xor(o[k], 32); }
      if (esub == 0) {
        float4* dst = (float4*)(stg + j * 128 + c16 * 8);
        dst[0] = make_float4(o[0], o[1], o[2], o[3]); dst[1] = make_float4(o[4], o[5], o[6], o[7]);
      }
      asm volatile("" ::: "memory");
      if (++j == 16) { flush_rows(stg, po, 2048, tok0, tstride, 16, sl * 128); j = 0; tok0 = tok + tstride; }
    }
    if (j) flush_rows(stg, po, 2048, tok0, tstride, j, sl * 128);
  }
}

__device__ __forceinline__ void phase16(const KArgs& a) {
  const int lane = threadIdx.x & 63; const int gw = blockIdx.x * 8 + (threadIdx.x >> 6); const int nw = gridDim.x * 8;
  const u16* po = (const u16*)(a.ws + OFF_R5); const float* g = a.in[29]; float* out = a.out;
  for (int r = gw; r < T; r += nw) {
    const uint2* p = (const uint2*)((const u16*)(a.ws + OFF_H1B) + (size_t)r * D); const uint2* q = (const uint2*)(po + (size_t)r * D);
    float4 v[8]; float ss = 0.f;
#pragma unroll
    for (int i = 0; i < 8; ++i) {
      const uint2 x = p[lane + i * 64]; const uint2 y = q[lane + i * 64];
      v[i] = make_float4(bflo(x.x) + bflo(y.x), bfhi(x.x) + bfhi(y.x), bflo(x.y) + bflo(y.y), bfhi(x.y) + bfhi(y.y));
      ss += v[i].x * v[i].x + v[i].y * v[i].y + v[i].z * v[i].z + v[i].w * v[i].w;
    }
    ss = wave_sum(ss);
    const float rs = rsqrtf(ss * (1.f / D) + 1e-6f);
#pragma unroll
    for (int i = 0; i < 8; ++i) {
      const float4 gg = ((const float4*)g)[lane + i * 64];
      ((float4*)(out + (size_t)r * D))[lane + i * 64] = make_float4(v[i].x * rs * gg.x, v[i].y * rs * gg.y, v[i].z * rs * gg.z, v[i].w * rs * gg.w);
    }
  }
}

__global__ void __launch_bounds__(NT) mega(KArgs a) {
  extern __shared__ __attribute__((aligned(16))) unsigned char ldsb[];
  u16* lds = (u16*)ldsb;
  cg::grid_group grid = cg::this_grid();
  const int lo = a.ph_lo, hi = a.ph_hi;
  volatile LAS unsigned* bst = (volatile LAS unsigned*)(LAS unsigned char*)(ldsb + LDS_BYTES - 16);
  if (threadIdx.x < 2) bst[threadIdx.x] = 0u;
  __syncthreads();
  XcdBarrier xbar; xbar.bar = (unsigned*)(a.ws + OFF_BAR); xbar.x = 0; xbar.st = bst;
#define GSYNC(k) do { if ((k) == 0) { grid.sync(); xbar = xcd_barrier_post((unsigned*)(a.ws + OFF_BAR), bst); } else xcd_barrier(xbar); } while (0)
#define PH(k, call) if (lo <= (k) && (k) < hi) { call; if ((k) + 1 < hi) GSYNC(k); }
  PH(0, phase0(a, ldsb))
  if (lo <= 1 && 1 < hi) census(a);
  PH(1, phase1(a, lds))
  PH(2, phase2(a, lds))
  PH(3, phase3(a, lds))
  PH(4, phase4(a, lds))
  PH(5, phase5(a, lds))
  PH(6, phase6(a))
  PH(7, phase7a(a, lds))
  PH(8, phase7b(a, lds))
  PH(9, phase8(a, lds))
  PH(10, phase9(a))
  PH(11, phase10(a, lds))
  PH(12, phase11(a, lds))
  PH(13, phase12(a, ldsb))
  PH(14, phase13(a, ldsb))
  PH(15, phase14(a))
  PH(16, phase15(a, ldsb))
  PH(17, phase16(a))
#undef PH
}

extern "C" void kernel_launch(void* const* d_in, const int* in_sizes, int n_in, void* d_out, int out_size, void* d_ws, size_t ws_size,
                              hipStream_t stream) {
  static int grid_blocks = 0;
  if (!grid_blocks) {
    if (ws_size < WS_END) { fprintf(stderr, "kernel_launch: workspace too small: %zu < %zu\n", ws_size, (size_t)WS_END); grid_blocks = -1; return; }
    int dev = 0, cus = 0, per_cu = 0;
    hipGetDevice(&dev);
    hipDeviceGetAttribute(&cus, hipDeviceAttributeMultiprocessorCount, dev);
    if (hipFuncSetAttribute((const void*)mega, hipFuncAttributeMaxDynamicSharedMemorySize, LDS_BYTES) != hipSuccess)
      fprintf(stderr, "kernel_launch: hipFuncSetAttribute failed\n");
    hipOccupancyMaxActiveBlocksPerMultiprocessor(&per_cu, (const void*)mega, NT, LDS_BYTES);
    if (per_cu < 1) { fprintf(stderr, "kernel_launch: occupancy query says %d blocks per CU\n", per_cu); per_cu = 1; }
    if (per_cu > 1) per_cu = 1;
    grid_blocks = cus * per_cu;
  }
  if (grid_blocks < 0) return;
  KArgs a{};
  for (int i = 0; i < 30; ++i) a.in[i] = (const float*)d_in[i];
  a.out = (float*)d_out; a.ws = (unsigned char*)d_ws;
#if MULTI
  for (int ph = 0; ph < NPH; ++ph) {
    a.ph_lo = ph; a.ph_hi = ph + 1;
    hipLaunchKernelGGL(mega, dim3(grid_blocks), dim3(NT), LDS_BYTES, stream, a);
  }
#else
  a.ph_lo = 0; a.ph_hi = NPH;
  void* args[] = {&a};
  hipError_t e = hipLaunchCooperativeKernel((const void*)mega, dim3(grid_blocks), dim3(NT), args, LDS_BYTES, stream);
  if (e != hipSuccess) fprintf(stderr, "cooperative launch failed: %s (grid %d)\n", hipGetErrorString(e), grid_blocks);
#endif
}
```
